# Optimizing an MI355X kernel written in HIP

```python
import jax, jax.numpy as jnp
from jax import lax
import numpy as np

D_MODEL = 1024
BATCH = 8
SEQ = 4096
DEPTH = 1

D_MIX = D_MODEL
D_POOL = D_MIX // 2
D_DN = D_MIX - D_POOL
POOL_WINDOWS = (2, 4, 8, 16)
N_POOL_GROUPS = len(POOL_WINDOWS)
POOL_GROUP = D_POOL // N_POOL_GROUPS
DN_HEAD_DIM = 128
DN_HEADS = D_DN // DN_HEAD_DIM
CONV_WIDTH = 4
CHUNK = 64
NORM_EPS = 1e-6
SPLIT_SIZES = (D_POOL, D_POOL, D_DN, D_DN, D_DN, D_DN, DN_HEADS, DN_HEADS)
D_IN = sum(SPLIT_SIZES)

kernel_name = "hymba_pool_gated_deltanet_block"


def rms_norm(x, w):
    xf = x.astype(jnp.float32)
    y = xf * lax.rsqrt(jnp.mean(xf * xf, axis=-1, keepdims=True) + NORM_EPS)
    return (y * w.astype(jnp.float32)).astype(x.dtype)


def l2_normalize(t):
    return t * lax.rsqrt(jnp.sum(t * t, axis=-1, keepdims=True) + NORM_EPS)


def pool_mixer(u, z, pool_w, pool_scale):
    B, S, _ = u.shape
    uf = u.astype(jnp.float32).reshape(B, S, N_POOL_GROUPS, POOL_GROUP)
    csum = jnp.cumsum(uf, axis=1)
    counts = jnp.arange(1, S + 1, dtype=jnp.float32)
    outs = []
    for gi, w in enumerate(POOL_WINDOWS):
        c = csum[:, :, gi]
        prev = jnp.pad(c, ((0, 0), (w, 0), (0, 0)))[:, :S]
        cnt = jnp.minimum(counts, float(w))[None, :, None]
        outs.append((c - prev) / cnt)
    mix = jnp.stack(outs, axis=2) - uf
    mix = jnp.einsum('bsgc,gcd->bsgd', mix, pool_w.astype(jnp.float32)).reshape(B, S, D_POOL)
    out = mix * pool_scale.astype(jnp.float32) * jax.nn.silu(z.astype(jnp.float32))
    return out.astype(u.dtype)


def causal_depthwise_conv(u, w):
    K, C = w.shape
    return lax.conv_general_dilated(
        u, w[:, None, :], window_strides=(1,), padding=[(K - 1, 0)],
        dimension_numbers=('NWC', 'WIO', 'NWC'), feature_group_count=C)


def gated_delta_rule(q, k, v, g, beta):
    B, H, S, dk = q.shape
    dv = v.shape[-1]
    n = S // CHUNK
    q = q * (dk ** -0.5)
    k_beta = k * beta[..., None]
    v_beta = v * beta[..., None]
    chunked = lambda t: t.reshape(B, H, n, CHUNK, t.shape[-1])
    q, k, k_beta, v_beta = chunked(q), chunked(k), chunked(k_beta), chunked(v_beta)
    gc = jnp.cumsum(g.reshape(B, H, n, CHUNK), axis=-1)
    causal = jnp.tril(jnp.ones((CHUNK, CHUNK), dtype=bool))
    strict = jnp.tril(jnp.ones((CHUNK, CHUNK), dtype=bool), k=-1)
    diff = gc[..., :, None] - gc[..., None, :]
    decay = jnp.exp(jnp.where(causal, diff, -jnp.inf))
    A = jnp.where(strict, jnp.einsum('bhncd,bhnmd->bhncm', k_beta, k) * decay, 0.0)
    eye = jnp.eye(CHUNK, dtype=jnp.float32)
    T = lax.linalg.triangular_solve(A + eye, jnp.broadcast_to(eye, A.shape),
                                    left_side=True, lower=True, unit_diagonal=True)
    u = jnp.einsum('bhncm,bhnmd->bhncd', T, v_beta)
    w = jnp.einsum('bhncm,bhnmd->bhncd', T, k_beta * jnp.exp(gc)[..., None])
    qk = jnp.einsum('bhncd,bhnmd->bhncm', q, k) * decay
    q_dec = q * jnp.exp(gc)[..., None]
    k_dec = k * jnp.exp(gc[..., -1:] - gc)[..., None]
    chunk_decay = jnp.exp(gc[..., -1])

    def step(state, xs):
        qk_i, q_dec_i, k_dec_i, u_i, w_i, dec_i = xs
        v_new = u_i - jnp.einsum('bhcd,bhde->bhce', w_i, state)
        o = jnp.einsum('bhcd,bhde->bhce', q_dec_i, state) + jnp.einsum('bhcm,bhme->bhce', qk_i, v_new)
        state = state * dec_i[..., None, None] + jnp.einsum('bhcd,bhce->bhde', k_dec_i, v_new)
        return state, o

    to_scan = lambda t: jnp.moveaxis(t, 2, 0)
    xs = (to_scan(qk), to_scan(q_dec), to_scan(k_dec), to_scan(u), to_scan(w), to_scan(chunk_decay))
    state0 = jnp.zeros((B, H, dk, dv), dtype=jnp.float32)
    _, o = lax.scan(step, state0, xs)
    return jnp.moveaxis(o, 0, 2).reshape(B, H, S, dv)


def deltanet_mixer(q, k, v, z, b, a, conv_w, a_log, dt_bias, norm_w):
    B, S, _ = q.shape
    out_dtype = q.dtype
    qkv = jnp.concatenate([q, k, v], axis=-1).astype(jnp.float32)
    qkv = jax.nn.silu(causal_depthwise_conv(qkv, conv_w.astype(jnp.float32)))
    q, k, v = jnp.split(qkv, 3, axis=-1)
    heads = lambda t: t.reshape(B, S, DN_HEADS, DN_HEAD_DIM).transpose(0, 2, 1, 3)
    q, k, v = l2_normalize(heads(q)), l2_normalize(heads(k)), heads(v)
    beta = jax.nn.sigmoid(b.astype(jnp.float32)).transpose(0, 2, 1)
    g = (-jnp.exp(a_log.astype(jnp.float32))
         * jax.nn.softplus(a.astype(jnp.float32) + dt_bias.astype(jnp.float32))).transpose(0, 2, 1)
    o = gated_delta_rule(q, k, v, g, beta).transpose(0, 2, 1, 3)
    o = o * lax.rsqrt(jnp.mean(o * o, axis=-1, keepdims=True) + NORM_EPS) * norm_w.astype(jnp.float32)
    o = o * jax.nn.silu(z.astype(jnp.float32).reshape(B, S, DN_HEADS, DN_HEAD_DIM))
    return o.reshape(B, S, D_DN).astype(out_dtype)


def setup_inputs(seed: int = 0) -> dict:
    key = jax.random.key(seed)
    ks = jax.random.split(key, 12)
    f32 = jnp.float32
    x = jax.random.normal(ks[0], (BATCH, SEQ, D_MODEL), f32)
    norm_w = 1.0 + 0.02 * jax.random.normal(ks[1], (DEPTH, D_MODEL), f32)
    w_in = jax.random.normal(ks[2], (DEPTH, D_MODEL, D_IN), f32) * D_MODEL ** -0.5
    pool_w = jax.random.normal(ks[3], (DEPTH, N_POOL_GROUPS, POOL_GROUP, POOL_GROUP), f32) * POOL_GROUP ** -0.5
    pool_scale = 1.0 + 0.1 * jax.random.normal(ks[4], (DEPTH, D_POOL), f32)
    conv_w = jax.random.normal(ks[5], (DEPTH, CONV_WIDTH, 3 * D_DN), f32) * CONV_WIDTH ** -0.5
    a_log = jnp.log(jax.random.uniform(ks[6], (DEPTH, DN_HEADS), f32, 1.0, 16.0))
    dt = jnp.exp(jax.random.uniform(ks[7], (DEPTH, DN_HEADS), f32, np.log(1e-3), np.log(1e-1)))
    dt_bias = dt + jnp.log(-jnp.expm1(-dt))
    dn_norm_w = 1.0 + 0.02 * jax.random.normal(ks[8], (DEPTH, DN_HEAD_DIM), f32)
    w_out = jax.random.normal(ks[9], (DEPTH, D_MIX, D_MODEL), f32) * D_MIX ** -0.5
    final_norm_w = 1.0 + 0.02 * jax.random.normal(ks[10], (D_MODEL,), f32)
    return {"x": x, "norm_w": norm_w, "w_in": w_in, "pool_w": pool_w, "pool_scale": pool_scale,
            "conv_w": conv_w, "a_log": a_log, "dt_bias": dt_bias, "dn_norm_w": dn_norm_w,
            "w_out": w_out, "final_norm_w": final_norm_w}


def reference(x, norm_w, w_in, pool_w, pool_scale, conv_w, a_log, dt_bias, dn_norm_w, w_out, final_norm_w):
    offsets = np.cumsum((0,) + SPLIT_SIZES)
    h = x
    for layer in range(DEPTH):
        n = rms_norm(h, norm_w[layer])
        proj = jnp.einsum('bsd,de->bse', n, w_in[layer])
        pu, pz, q, k, v, dz, b, a = [proj[..., int(offsets[i]):int(offsets[i + 1])]
                                     for i in range(len(SPLIT_SIZES))]
        y_pool = pool_mixer(pu, pz, pool_w[layer], pool_scale[layer])
        y_dn = deltanet_mixer(q, k, v, dz, b, a, conv_w[layer], a_log[layer],
                              dt_bias[layer], dn_norm_w[layer])
        y = jnp.concatenate([y_pool, y_dn], axis=-1)
        h = h + jnp.einsum('bse,ed->bsd', y, w_out[layer])
    return rms_norm(h, final_norm_w)
```

```cpp
#include <hip/hip_runtime.h>
#include <cstdio>
#include <cstdint>
namespace pg8 {
#define PG8_LAS __attribute__((address_space(3)))
typedef unsigned short bf16_t;
typedef short bf16x8 __attribute__((ext_vector_type(8)));
typedef float f32x4 __attribute__((ext_vector_type(4)));
typedef unsigned u32x4 __attribute__((ext_vector_type(4)));
constexpr int BM = 256, BK = 64, HALF = 128, HTB = HALF * BK * 2  , STAGE_BYTES = 8 * HTB, NXCD = 8, WGM = 8;

__host__ __device__ __forceinline__ int lds_byte(int r, int c) { const int st = (r >> 4) * 2 + (c >> 5), rr = r & 15, cc = c & 31, ob = rr * 64 + cc * 2; return st * 1024 + (ob ^ (((ob >> 9) & 1) << 5)); }
__host__ __device__ __forceinline__ void stage_rc(int b, int& R, int& C) { const int st = b / 1024, sb = b % 1024, swz = sb ^ (((sb >> 9) & 1) << 5); R = (st >> 1) * 16 + swz / 64; C = (st & 1) * 32 + (swz % 64) / 2; }
__host__ __device__ __forceinline__ int perm32(int rho) { const int n = rho >> 4, i = rho & 15; return 8 * (i >> 2) + 4 * n + (i & 3); }

struct Unit { int pm, pn; };
struct Gemm { const bf16_t* A; const bf16_t* Bt; int M, N, K; };

struct StaticOrder {
    int nM, nN, nwg, G, c;
    __host__ __device__ void init(int M, int N, int G_, int c_) { nM = M / BM; nN = N / BM; nwg = nM * nN; G = G_; c = c_; }
    __host__ __device__ bool next(int i, Unit& u) const {
        const long L = (long)i * G + c; if (L >= nwg) return false;
        int wgid = (int)L; { const int q = nwg / NXCD, r = nwg % NXCD, xcd = wgid % NXCD, off = wgid / NXCD; wgid = (xcd < r ? xcd * (q + 1) : r * (q + 1) + (xcd - r) * q) + off; }
        const int nig = WGM * nN, gid = wgid / nig, fm = gid * WGM, gsz = (nM - fm) < WGM ? (nM - fm) : WGM;
        u.pm = fm + ((wgid % nig) % gsz); u.pn = (wgid % nig) / gsz; return true;
    }
    __device__ __forceinline__ void a_ready(const Unit&) const {}
    __device__ __forceinline__ void done(const Unit&) const {}
};

__device__ __forceinline__ unsigned cvt_pk_bf16(float lo, float hi) { unsigned r; asm volatile("v_cvt_pk_bf16_f32 %0, %1, %2" : "=v"(r) : "v"(lo), "v"(hi)); return r; }
typedef float f32x2 __attribute__((ext_vector_type(2)));
__device__ __forceinline__ float silu_f(float v) { return v * __builtin_amdgcn_rcpf(1.0f + __builtin_amdgcn_exp2f(v * -1.4426950408889634f)); }

struct EpiProj {
    static constexpr bool PERM = true, AFTER_DRAIN = false;
    bf16_t* O; size_t seg_stride;
    __device__ __forceinline__ void operator()(const f32x4 (&acc)[2][2][4][2], const Unit& u, int wr, int wc, int fr, int fq) const {
        const int row0 = u.pm * BM + wr * 64 + fr; const int colt0 = u.pn * BM; const int t = colt0 / 512; const int colt = colt0 - t * 512;
        bf16_t* base = O + (size_t)t * seg_stride; const bool act = (t == 1) || (t == 5);
        const int col0 = colt + wc * 32 + 8 * fq;
#pragma unroll
        for (int ai = 0; ai < 2; ++ai)
#pragma unroll
            for (int m = 0; m < 4; ++m) { bf16_t* rowp = base + (size_t)(row0 + ai * HALF + m * 16) * 512 + col0;
#pragma unroll
                for (int bj = 0; bj < 2; ++bj) { f32x4 v0 = acc[ai][bj][m][0], v1 = acc[ai][bj][m][1];
                    if (act) {
#pragma unroll
                        for (int e = 0; e < 4; ++e) { v0[e] = silu_f(v0[e]); v1[e] = silu_f(v1[e]); } }
                    u32x4 w; w.x = cvt_pk_bf16(v0[0], v0[1]); w.y = cvt_pk_bf16(v0[2], v0[3]); w.z = cvt_pk_bf16(v1[0], v1[1]); w.w = cvt_pk_bf16(v1[2], v1[3]);
                    *(u32x4*)(rowp + bj * HALF) = w; } }
    }
};

struct EpiResF32 {
    static constexpr bool PERM = false, AFTER_DRAIN = false;
    const float* base; float* C; int ldc;
    __device__ __forceinline__ void operator()(const f32x4 (&acc)[2][2][4][2], const Unit& u, int wr, int wc, int fr, int fq) const {
        const int row0 = u.pm * BM + wr * 64 + fr, col0 = u.pn * BM + wc * 32 + 4 * fq;
#pragma unroll
        for (int ai = 0; ai < 2; ++ai)
#pragma unroll
            for (int m = 0; m < 4; ++m) { const size_t off = (size_t)(row0 + ai * HALF + m * 16) * ldc + col0;
#pragma unroll
                for (int bj = 0; bj < 2; ++bj)
#pragma unroll
                    for (int n = 0; n < 2; ++n) *(f32x4*)(C + off + bj * HALF + n * 16) = *(const f32x4*)(base + off + bj * HALF + n * 16) + acc[ai][bj][m][n]; }
    }
};
template <class Epi, class Sched, bool ALIGN_EPI = false, bool SP2 = false>
__device__ __forceinline__ void gemm_phase(PG8_LAS unsigned char* lds, const Gemm g, const Sched& S, const Epi& E) {
    const int tid = threadIdx.x, wid = __builtin_amdgcn_readfirstlane(tid >> 6), lane = tid & 63, wr = wid >> 2, wc = wid & 3, fr = lane & 15, fq = lane >> 4;
    const int K = g.K, nt = K / BK;
    unsigned voffA[2], voffB[2];
#pragma unroll
    for (int i = 0; i < 2; ++i) { int R, C; stage_rc(tid * 16 + i * 8192, R, C); const int Rb = Epi::PERM ? ((R & ~31) + perm32(R & 31)) : R;
        voffA[i] = (unsigned)(R * K + C) * 2u; voffB[i] = (unsigned)(Rb * K + C) * 2u; }
    const size_t kstep = (size_t)(BK * 2);
    const size_t hstep = (size_t)HALF * K * 2;
    const size_t tstep = 2 * hstep;
    const unsigned ldsw = (unsigned)wid * 1024u;
    const int aoff = lds_byte(wr * 64 + fr, fq * 8), boff = lds_byte(wc * 32 + fr, fq * 8);
#define PG8_SA(b, h) (((b) * 2 + (h)) * HTB)
#define PG8_SB(b, h) ((4 + (b) * 2 + (h)) * HTB)
#define PG8_STAGE(bufoff, gbase, voff) do { _Pragma("unroll") for (int _i = 0; _i < 2; ++_i) \
        __builtin_amdgcn_global_load_lds((const unsigned*)((const char*)(gbase) + (voff)[_i]), (PG8_LAS unsigned*)(lds + (bufoff) + ldsw + _i * 8192), 16, 0, 0); } while (0)
#define PG8_LDA(dst, b, h) do { _Pragma("unroll") for (int m = 0; m < 4; ++m) _Pragma("unroll") for (int k = 0; k < 2; ++k) dst[m][k] = *(const PG8_LAS bf16x8*)(lds + PG8_SA(b, h) + aoff + m * 2048 + k * 1024); } while (0)
#define PG8_LDB(dst, b, h) do { _Pragma("unroll") for (int n = 0; n < 2; ++n) _Pragma("unroll") for (int k = 0; k < 2; ++k) dst[n][k] = *(const PG8_LAS bf16x8*)(lds + PG8_SB(b, h) + boff + n * 2048 + k * 1024); } while (0)
#define PG8_MMA(ai, bj, At, Bt) do { __builtin_amdgcn_s_setprio(1); _Pragma("unroll") for (int m = 0; m < 4; ++m) _Pragma("unroll") for (int n = 0; n < 2; ++n) _Pragma("unroll") for (int k = 0; k < 2; ++k) \
        acc[ai][bj][m][n] = __builtin_amdgcn_mfma_f32_16x16x32_bf16(Bt[n][k], At[m][k], acc[ai][bj][m][n], 0, 0, 0); __builtin_amdgcn_s_setprio(0); } while (0)
#define PG8_WAIT_V(n) asm volatile("s_waitcnt vmcnt(" #n ")" ::: "memory")
#define PG8_WAIT_L(n) asm volatile("s_waitcnt lgkmcnt(" #n ")" ::: "memory")
#define PG8_BAR __builtin_amdgcn_s_barrier()
#define PG8_SCHED __builtin_amdgcn_sched_barrier(0)
    Unit cur, nxt; int ui = 0;
    if (!S.next(0, cur)) return;
    f32x4 acc[2][2][4][2];
#pragma unroll
    for (int a = 0; a < 2; ++a)
#pragma unroll
        for (int b = 0; b < 2; ++b)
#pragma unroll
            for (int m = 0; m < 4; ++m)
#pragma unroll
                for (int n = 0; n < 2; ++n) acc[a][b][m][n] = (f32x4){0.f, 0.f, 0.f, 0.f};
    bf16x8 At[4][2], B0[2][2], B1[2][2];
    const char* cA = (const char*)g.A + (size_t)cur.pm * tstep; const char* cB = (const char*)g.Bt + (size_t)cur.pn * tstep;
    S.a_ready(cur);
    if constexpr (SP2) {
        PG8_STAGE(PG8_SB(0, 0), cB, voffB); PG8_STAGE(PG8_SB(0, 1), cB + hstep, voffB); PG8_STAGE(PG8_SA(0, 0), cA, voffA); PG8_STAGE(PG8_SA(0, 1), cA + hstep, voffA);
        if (wr == 1) PG8_BAR;
        PG8_WAIT_V(2); PG8_BAR;
        PG8_STAGE(PG8_SB(1, 0), cB + kstep, voffB); PG8_STAGE(PG8_SA(1, 0), cA + kstep, voffA); PG8_STAGE(PG8_SB(1, 1), cB + hstep + kstep, voffB);
        PG8_WAIT_V(6); PG8_BAR;
    } else {
        PG8_STAGE(PG8_SB(0, 0), cB, voffB); PG8_STAGE(PG8_SA(0, 0), cA, voffA); PG8_STAGE(PG8_SB(0, 1), cB + hstep, voffB); PG8_STAGE(PG8_SA(0, 1), cA + hstep, voffA);
        if (wr == 1) PG8_BAR;
        PG8_WAIT_V(4); PG8_BAR;
        PG8_STAGE(PG8_SB(1, 0), cB + kstep, voffB); PG8_STAGE(PG8_SA(1, 0), cA + kstep, voffA); PG8_STAGE(PG8_SB(1, 1), cB + hstep + kstep, voffB);
        PG8_WAIT_V(6); PG8_BAR;
    }
    for (;;) {
        const bool has_next = S.next(ui + 1, nxt);
        const char* nA = has_next ? (const char*)g.A + (size_t)nxt.pm * tstep : cA; const char* nB = has_next ? (const char*)g.Bt + (size_t)nxt.pn * tstep : cB;
        for (int t = 0; t < nt; t += 2) {
            const bool last = (t == nt - 2);
            const char* a1 = cA + (size_t)(t + 1) * kstep;
            const char* a2 = last ? nA : cA + (size_t)(t + 2) * kstep; const char* b2 = last ? nB : cB + (size_t)(t + 2) * kstep;
            const char* a3 = a2 + kstep; const char* b3 = b2 + kstep;
            if (last && has_next) S.a_ready(nxt);
            if constexpr (SP2) {
            PG8_LDB(B0, 0, 0); PG8_LDB(B1, 0, 1); PG8_SCHED; PG8_LDA(At, 0, 0); PG8_STAGE(PG8_SA(1, 1), a1 + hstep, voffA);
            PG8_WAIT_V(8); PG8_WAIT_L(0); PG8_BAR; PG8_MMA(0, 0, At, B0); PG8_MMA(0, 1, At, B1); PG8_BAR; PG8_SCHED;
            PG8_LDA(At, 0, 1); PG8_STAGE(PG8_SB(0, 0), b2, voffB); PG8_STAGE(PG8_SB(0, 1), b2 + hstep, voffB); PG8_STAGE(PG8_SA(0, 0), a2, voffA);
            PG8_WAIT_V(8); PG8_WAIT_L(0); PG8_BAR; PG8_MMA(1, 0, At, B0); PG8_MMA(1, 1, At, B1); PG8_BAR; PG8_SCHED;
            PG8_LDB(B0, 1, 0); PG8_LDB(B1, 1, 1); PG8_SCHED; PG8_LDA(At, 1, 0); PG8_STAGE(PG8_SA(0, 1), a2 + hstep, voffA);
            PG8_WAIT_V(8); PG8_WAIT_L(0); PG8_BAR; PG8_MMA(0, 0, At, B0); PG8_MMA(0, 1, At, B1); PG8_BAR; PG8_SCHED;
            PG8_LDA(At, 1, 1); PG8_STAGE(PG8_SB(1, 0), b3, voffB); PG8_STAGE(PG8_SB(1, 1), b3 + hstep, voffB); PG8_STAGE(PG8_SA(1, 0), a3, voffA);
            PG8_WAIT_V(8); PG8_WAIT_L(0); PG8_BAR; PG8_MMA(1, 0, At, B0); PG8_MMA(1, 1, At, B1); PG8_BAR; PG8_SCHED;
            } else {
            PG8_LDB(B0, 0, 0); PG8_SCHED; PG8_LDA(At, 0, 0); PG8_STAGE(PG8_SA(1, 1), a1 + hstep, voffA);
            PG8_WAIT_L(8); PG8_BAR; PG8_WAIT_L(0); PG8_MMA(0, 0, At, B0); PG8_BAR; PG8_SCHED;
            PG8_LDB(B1, 0, 1); PG8_STAGE(PG8_SB(0, 0), b2, voffB);
            PG8_BAR; PG8_WAIT_L(0); PG8_MMA(0, 1, At, B1); PG8_BAR;
            PG8_LDA(At, 0, 1); PG8_STAGE(PG8_SA(0, 0), a2, voffA);
            PG8_BAR; PG8_WAIT_L(0); PG8_MMA(1, 0, At, B0); PG8_BAR; PG8_SCHED;
            PG8_STAGE(PG8_SB(0, 1), b2 + hstep, voffB);
            PG8_WAIT_V(6); PG8_BAR; PG8_MMA(1, 1, At, B1); PG8_BAR;
            PG8_LDB(B0, 1, 0); PG8_SCHED; PG8_LDA(At, 1, 0); PG8_STAGE(PG8_SA(0, 1), a2 + hstep, voffA);
            PG8_WAIT_L(8); PG8_BAR; PG8_WAIT_L(0); PG8_MMA(0, 0, At, B0); PG8_BAR; PG8_SCHED;
            PG8_LDB(B1, 1, 1); PG8_STAGE(PG8_SB(1, 0), b3, voffB);
            PG8_BAR; PG8_WAIT_L(0); PG8_MMA(0, 1, At, B1); PG8_BAR;
            PG8_LDA(At, 1, 1); PG8_STAGE(PG8_SA(1, 0), a3, voffA);
            PG8_BAR; PG8_WAIT_L(0); PG8_MMA(1, 0, At, B0); PG8_BAR; PG8_SCHED;
            PG8_STAGE(PG8_SB(1, 1), b3 + hstep, voffB);
            PG8_WAIT_V(6); PG8_BAR; PG8_MMA(1, 1, At, B1); PG8_BAR;
            }
        }
        if constexpr (ALIGN_EPI) { if (wr == 0) PG8_BAR; }
        if constexpr (!Epi::AFTER_DRAIN) { E(acc, cur, wr, wc, fr, fq); S.done(cur); }
        if (!has_next) break;
#pragma unroll
        for (int a = 0; a < 2; ++a)
#pragma unroll
            for (int b = 0; b < 2; ++b)
#pragma unroll
                for (int m = 0; m < 4; ++m)
#pragma unroll
                    for (int n = 0; n < 2; ++n) acc[a][b][m][n] = (f32x4){0.f, 0.f, 0.f, 0.f};
        cur = nxt; cA = nA; cB = nB; ++ui;
        if constexpr (ALIGN_EPI) { if (wr == 1) PG8_BAR; }
    }
    PG8_WAIT_V(0);
    if constexpr (!ALIGN_EPI) { if (wr == 0) PG8_BAR; }
    PG8_BAR;
    if constexpr (Epi::AFTER_DRAIN) { E.fused(acc, cur, wr, wc, fr, fq, lds, wid, lane); S.done(cur); }
#undef PG8_SA
#undef PG8_SB
#undef PG8_STAGE
#undef PG8_LDA
#undef PG8_LDB
#undef PG8_MMA
#undef PG8_WAIT_V
#undef PG8_WAIT_L
#undef PG8_BAR
#undef PG8_SCHED
}
}
#define GAS __attribute__((address_space(1)))
#define LAS __attribute__((address_space(3)))
typedef unsigned short bf16;
typedef unsigned v4u __attribute__((ext_vector_type(4)));
typedef float f32x4 __attribute__((ext_vector_type(4)));
typedef short bf16x8 __attribute__((ext_vector_type(8)));
typedef GAS unsigned gu32;
typedef GAS unsigned long long gu64;
#define RLX_AGENT __ATOMIC_RELAXED, __HIP_MEMORY_SCOPE_AGENT
#define LDS_WAIT() asm volatile("s_waitcnt lgkmcnt(0)" ::: "memory")
#define VM_WAIT() asm volatile("s_waitcnt vmcnt(0)" ::: "memory")
__device__ __forceinline__ unsigned long long rt() { return __builtin_amdgcn_s_memrealtime(); }
__device__ __forceinline__ unsigned f2bf(float f) { unsigned u = __builtin_bit_cast(unsigned, f); return (u + 0x7fffu + ((u >> 16) & 1u)) >> 16; }
__device__ __forceinline__ unsigned pk2(float lo, float hi) { return f2bf(lo) | (f2bf(hi) << 16); }

#define XB_TMO      128
#define XB_XCNT(j)  (256  + 64 * (j))
#define XB_XSUB(j)  (1280 + 64 * (j))
#define XB_XGEN(j)  (2304 + 64 * (j))
#define XB_TOP      3328
#define XB_TOPGEN   3392
#define XCD_BAR_WORDS 3456
#define XB_SPIN_CAP (1u << 18)

__device__ __forceinline__ unsigned xb_ld(unsigned* p)              { return __hip_atomic_load(p, __ATOMIC_RELAXED, __HIP_MEMORY_SCOPE_AGENT); }
__device__ __forceinline__ unsigned xb_add(unsigned* p, unsigned v) { return __hip_atomic_fetch_add(p, v, __ATOMIC_RELAXED, __HIP_MEMORY_SCOPE_AGENT); }
__device__ __forceinline__ unsigned xb_xcc_id() { return (unsigned)__builtin_amdgcn_s_getreg((3 << 11) | 20) & 0xFu; }
#define XB_SPIN(cond, bar) do { unsigned _sp = 0; while (cond) { __builtin_amdgcn_s_sleep(1); \
    if ((++_sp & 255u) == 0u) { if (xb_ld(&(bar)[XB_TMO])) break; if (_sp > XB_SPIN_CAP) { atomicAdd(&(bar)[XB_TMO], 1u); break; } } } } while (0)

struct XcdBarrier {
    unsigned* bar; unsigned x;
    volatile LAS unsigned* st;
};

__device__ __forceinline__ XcdBarrier xcd_barrier_post(unsigned* bar, volatile LAS unsigned* st) {
    XcdBarrier b; b.bar = bar; b.x = xb_xcc_id(); b.st = st;
    if (threadIdx.x == 0) (void)xb_add(&bar[XB_XCNT(b.x)], 1u);
    return b;
}
__device__ __forceinline__ void xcd_barrier_complete(unsigned* bar, unsigned x, unsigned& nloc, unsigned& nx) {
    const unsigned G = gridDim.x * gridDim.y * gridDim.z;
    unsigned sum, cnt, mine, sp = 0u;
    for (;;) {
        sum = 0u; cnt = 0u; mine = 0u;
#pragma unroll
        for (unsigned j = 0; j < 16; ++j) { const unsigned c = xb_ld(&bar[XB_XCNT(j)]); sum += c; cnt += (c > 0u) ? 1u : 0u; mine = (j == x) ? c : mine; }
        if (sum == G) break;
        __builtin_amdgcn_s_sleep(1);
        if ((++sp & 255u) == 0u) { if (xb_ld(&bar[XB_TMO])) break; if (sp > XB_SPIN_CAP) { atomicAdd(&bar[XB_TMO], 1u); break; } }
    }
    nloc = mine > 0u ? mine : 1u; nx = cnt > 0u ? cnt : 1u;
}

__device__ __forceinline__ void xcd_barrier(const XcdBarrier& b) {
    asm volatile("s_waitcnt vmcnt(0)" ::: "memory");
    __syncthreads();
    if (threadIdx.x == 0) {
        unsigned* bar = b.bar;
        __builtin_amdgcn_s_waitcnt(0);
        unsigned nloc = b.st[0], nx = b.st[1];
        if (nloc == 0u) { xcd_barrier_complete(bar, b.x, nloc, nx); b.st[0] = nloc; b.st[1] = nx; }
        const unsigned old = xb_add(&bar[XB_XSUB(b.x)], 1u);
        const unsigned gen = old / nloc;
        if (old + 1u == (gen + 1u) * nloc) {
            __builtin_amdgcn_fence(__ATOMIC_RELEASE, "agent");
            asm volatile("s_waitcnt vmcnt(0)" ::: "memory");
            const unsigned og = xb_add(&bar[XB_TOP], 1u);
            const unsigned tg = og / nx;
            if (og + 1u == (tg + 1u) * nx) xb_add(&bar[XB_TOPGEN], 1u);
            else XB_SPIN(xb_ld(&bar[XB_TOPGEN]) == tg, bar);
            __builtin_amdgcn_fence(__ATOMIC_ACQUIRE, "agent");
            xb_add(&bar[XB_XGEN(b.x)], 1u);
            asm volatile("s_waitcnt vmcnt(0)" ::: "memory");
        } else {
            XB_SPIN(xb_ld(&bar[XB_XGEN(b.x)]) == gen, bar);
            __builtin_amdgcn_fence(__ATOMIC_ACQUIRE, "agent");
            asm volatile("s_waitcnt vmcnt(0)" ::: "memory");
        }
    }
    __syncthreads();
}
typedef float f32x2 __attribute__((ext_vector_type(2)));

constexpr int NWAVES = 8;
#ifndef MK_N_LAUNCHES
#define MK_N_LAUNCHES 1
#endif
constexpr int N_LAUNCHES = MK_N_LAUNCHES;
constexpr int N_PHASES = 7;
constexpr int BATCH = 8, SEQ = 4096, DM = 1024, M = BATCH * SEQ;
constexpr int DIN = 3080, NPROJ = 3072, NH = 4, HD = 128, DDN = 512, DPOOL = 512, NSEG = 6;
constexpr float EPS = 1e-6f;
constexpr size_t MiB = 1u << 20;
constexpr size_t WS_CTL = 0, CTL_ZERO_BYTES = 1 * MiB;
constexpr size_t WS_WIN = 2 * MiB, WS_WOUT = 8 * MiB;
constexpr size_t WS_BETA = 10 * MiB, WS_G = 10 * MiB + 512 * 1024;
constexpr size_t WS_PROJ = 16 * MiB, SEG_BYTES = 32 * MiB;
constexpr size_t WS_XN = 208 * MiB;
constexpr size_t WS_QN = 208 * MiB, WS_KN = 272 * MiB, WS_VV = 336 * MiB, WS_O = 400 * MiB;
constexpr size_t WS_Y = 80 * MiB;
constexpr size_t WS_END = 464 * MiB;
constexpr int CW_BAR = 4096;
constexpr int RING_OFF = 0, RING_BYTES = 131072;
constexpr int LDSCTL_OFF = RING_BYTES, MISC_OFF = LDSCTL_OFF + 320;
constexpr int LDS_BYTES = 147456;

struct Frame {
    LAS unsigned char* lds;
    volatile LAS unsigned* MISC;
    gu32* ctl;
    int tid, lane, wave, vcu, G;
};
__device__ __forceinline__ float wave_sum(float v) {
#pragma unroll
    for (int o = 1; o < 64; o <<= 1) v += __shfl_xor(v, o);
    return v;
}
__device__ __forceinline__ float bf2f(unsigned short u) { return __uint_as_float((unsigned)u << 16); }
__device__ __forceinline__ float bflo(unsigned u) { return __uint_as_float(u << 16); }
__device__ __forceinline__ float bfhi(unsigned u) { return __uint_as_float(u & 0xffff0000u); }
__device__ __forceinline__ float silu(float v) { return v / (1.0f + __expf(-v)); }

__device__ __forceinline__ void p0_transpose_item(const float* W, int K, int ldw, int nblk, bf16* WT, LAS float* scr, int item, int lane) {
    const int kb = item / nblk, nb = item % nblk, k0 = 64 * kb, n0 = 32 * nb;
#pragma unroll 8
    for (int i = 0; i < 32; ++i) { const int kk = 2 * i + (lane >> 5); scr[kk * 33 + (lane & 31)] = W[(size_t)(k0 + kk) * ldw + n0 + (lane & 31)]; }
    LDS_WAIT(); asm volatile("" ::: "memory");
    const int c = lane & 7;
#pragma unroll
    for (int j = 0; j < 4; ++j) { const int n = (lane >> 3) + 8 * j; const LAS float* s = scr + (8 * c) * 33 + n;
        v4u o; o.x = pk2(s[0 * 33], s[1 * 33]); o.y = pk2(s[2 * 33], s[3 * 33]); o.z = pk2(s[4 * 33], s[5 * 33]); o.w = pk2(s[6 * 33], s[7 * 33]);
        *(GAS v4u*)(WT + (size_t)(n0 + n) * K + k0 + 8 * c) = o; }
    LDS_WAIT(); asm volatile("" ::: "memory");
}

struct Args { const float* in[11]; float* out; unsigned char* ws; int ph_lo, ph_hi; };

__device__ __forceinline__ void p0_prologue(Frame& F, const Args& A) {
    unsigned char* ws = A.ws;
    const float* x = A.in[0]; const float* norm_w = A.in[1]; const float* w_in = A.in[2]; const float* a_log = A.in[6]; const float* dt_bias = A.in[7]; const float* w_out = A.in[9];
    bf16* win_t = (bf16*)(ws + WS_WIN); bf16* wout_t = (bf16*)(ws + WS_WOUT); bf16* XN = (bf16*)(ws + WS_XN);
    float* beta = (float*)(ws + WS_BETA); float* gg = (float*)(ws + WS_G);
    LAS float* scr = (LAS float*)(F.lds + RING_OFF + F.wave * 16384);
    const int gw = F.vcu * NWAVES + F.wave, NGW = F.G * NWAVES;
    constexpr int I_IN = (DM / 64) * (NPROJ / 32), I_OUT = (DM / 64) * (DM / 32);
    for (int it = gw; it < I_IN + I_OUT; it += NGW) {
        if (it < I_IN) p0_transpose_item(w_in, DM, DIN, NPROJ / 32, win_t, scr, it, F.lane);
        else p0_transpose_item(w_out, DM, DM, DM / 32, wout_t, scr, it - I_IN, F.lane);
    }
    f32x4 nw[4];
#pragma unroll
    for (int j = 0; j < 4; ++j) nw[j] = *(const f32x4*)(norm_w + 4 * F.lane + 256 * j);
    float alog[4], dtb[4];
#pragma unroll
    for (int h = 0; h < 4; ++h) { alog[h] = a_log[h]; dtb[h] = dt_bias[h]; }
    for (int m = gw; m < M; m += NGW) {
        const GAS f32x4* xr = (const GAS f32x4*)(x + (size_t)m * DM) + F.lane;
        f32x4 v[4]; float s2 = 0.f;
#pragma unroll
        for (int j = 0; j < 4; ++j) { v[j] = xr[64 * j]; s2 += (v[j].x * v[j].x + v[j].y * v[j].y) + (v[j].z * v[j].z + v[j].w * v[j].w); }
        const float rstd = 1.0f / sqrtf(wave_sum(s2) * (1.f / DM) + EPS);
#pragma unroll
        for (int j = 0; j < 4; ++j) v[j] = v[j] * rstd * nw[j];
        GAS unsigned long long* o8 = (GAS unsigned long long*)(XN + (size_t)m * DM) + F.lane;
#pragma unroll
        for (int j = 0; j < 4; ++j) o8[64 * j] = (unsigned long long)pk2(v[j].x, v[j].y) | ((unsigned long long)pk2(v[j].z, v[j].w) << 32);
        float ga[8];
#pragma unroll
        for (int c = 0; c < 8; ++c) ga[c] = 0.f;
#pragma unroll
        for (int j = 0; j < 4; ++j)
#pragma unroll
            for (int e = 0; e < 4; ++e) { const int k = 4 * F.lane + 256 * j + e; const f32x4 w0 = *(const f32x4*)(w_in + (size_t)k * DIN + NPROJ), w1 = *(const f32x4*)(w_in + (size_t)k * DIN + NPROJ + 4);
                const float xv = v[j][e];
                ga[0] += xv * w0.x; ga[1] += xv * w0.y; ga[2] += xv * w0.z; ga[3] += xv * w0.w; ga[4] += xv * w1.x; ga[5] += xv * w1.y; ga[6] += xv * w1.z; ga[7] += xv * w1.w; }
#pragma unroll
        for (int c = 0; c < 8; ++c) ga[c] = wave_sum(ga[c]);
        if (F.lane < 4) { const int h = F.lane; const float bl = h == 0 ? ga[0] : h == 1 ? ga[1] : h == 2 ? ga[2] : ga[3]; const float al = h == 0 ? ga[4] : h == 1 ? ga[5] : h == 2 ? ga[6] : ga[7];
            const float al_ = h == 0 ? alog[0] : h == 1 ? alog[1] : h == 2 ? alog[2] : alog[3]; const float db_ = h == 0 ? dtb[0] : h == 1 ? dtb[1] : h == 2 ? dtb[2] : dtb[3];
            const float z = al + db_; const float sp = fmaxf(z, 0.f) + log1pf(__expf(-fabsf(z)));
            beta[(size_t)m * 4 + h] = 1.0f / (1.0f + __expf(-bl)); gg[(size_t)m * 4 + h] = -__expf(al_) * sp; }
    }
}

__device__ __forceinline__ void p2_naive(Frame& F, const Args& A) {
    unsigned char* ws = A.ws; const float* conv_w = A.in[5];
    const int gw = F.vcu * NWAVES + F.wave, NGW = F.G * NWAVES;
    for (int m = gw; m < M; m += NGW) { const int s = m % SEQ;
#pragma unroll 1
        for (int i = 0; i < 12; ++i) { const int seg = i >> 2, h = i & 3, ch = h * HD + 2 * F.lane;
            const bf16* src = (const bf16*)(ws + WS_PROJ + (size_t)(2 + seg) * SEG_BYTES);
            float* dst = (float*)(ws + (seg == 0 ? WS_QN : seg == 1 ? WS_KN : WS_VV));
            float a0 = 0.f, a1 = 0.f;
#pragma unroll
            for (int j = 0; j < 4; ++j) { const int r = s - 3 + j; if (r >= 0) { const unsigned u = *(const unsigned*)(src + (size_t)(m - 3 + j) * 512 + ch); const f32x2 w = *(const f32x2*)(conv_w + (size_t)j * 1536 + seg * 512 + ch);
                    a0 += w.x * bflo(u); a1 += w.y * bfhi(u); } }
            a0 = silu(a0); a1 = silu(a1);
            if (seg < 2) { const float ss = wave_sum(a0 * a0 + a1 * a1); float sc = 1.0f / sqrtf(ss + EPS); if (seg == 0) sc *= 0.08838834764831845f; a0 *= sc; a1 *= sc; }
            *(f32x2*)(dst + (size_t)m * 512 + ch) = (f32x2){a0, a1}; } }
}

__device__ __forceinline__ void p3_naive(Frame& F, const Args& A) {
    if (blockIdx.x >= BATCH * NH) return;
    unsigned char* ws = A.ws; const int bb = blockIdx.x / NH, h = blockIdx.x % NH;
    const float* QN = (const float*)(ws + WS_QN); const float* KN = (const float*)(ws + WS_KN); const float* VV = (const float*)(ws + WS_VV); float* O = (float*)(ws + WS_O);
    const float* beta = (const float*)(ws + WS_BETA); const float* gg = (const float*)(ws + WS_G);
    constexpr int TB = 16;
    LAS float* lk = (LAS float*)(F.lds); LAS float* lq = lk + TB * 128; LAS float* lv = lq + TB * 128; LAS float* lb = lv + TB * 128; LAS float* la = lb + TB;
    float S[64];
#pragma unroll
    for (int d = 0; d < 64; ++d) S[d] = 0.f;
    const int e = F.tid >> 1, half = F.tid & 1;
    for (int t0 = 0; t0 < SEQ; t0 += TB) {
        __syncthreads();
        for (int idx = F.tid; idx < TB * 128; idx += NWAVES * 64) { const int tok = idx >> 7, d = idx & 127; const size_t off = (size_t)(bb * SEQ + t0 + tok) * 512 + h * HD + d;
            lk[idx] = KN[off]; lq[idx] = QN[off]; lv[idx] = VV[off]; }
        if (F.tid < TB) { const size_t mo = (size_t)(bb * SEQ + t0 + F.tid) * 4 + h; lb[F.tid] = beta[mo]; la[F.tid] = __expf(gg[mo]); }
        __syncthreads();
        if (F.tid < 256) {
#pragma unroll 1
            for (int tok = 0; tok < TB; ++tok) { const float a = la[tok], bt = lb[tok]; const LAS float* kp = lk + tok * 128 + half * 64; const LAS float* qp = lq + tok * 128 + half * 64;
                float ks = 0.f;
#pragma unroll
                for (int d = 0; d < 64; ++d) ks += kp[d] * S[d];
                ks += __shfl_xor(ks, 1);
                const float vn = bt * (lv[tok * 128 + e] - a * ks);
                float o = 0.f;
#pragma unroll
                for (int d = 0; d < 64; ++d) { S[d] = a * S[d] + kp[d] * vn; o += qp[d] * S[d]; }
                o += __shfl_xor(o, 1);
                if (half == 0) O[(size_t)(bb * SEQ + t0 + tok) * 512 + h * HD + e] = o; }
        }
    }
}

__device__ __forceinline__ void p4_naive(Frame& F, const Args& A) {
    unsigned char* ws = A.ws; const float* pool_w = A.in[3]; const float* pool_scale = A.in[4]; const float* dn_norm_w = A.in[8];
    const float* O = (const float*)(ws + WS_O); bf16* Y = (bf16*)(ws + WS_Y);
    const bf16* PU = (const bf16*)(ws + WS_PROJ); const bf16* PZ = (const bf16*)(ws + WS_PROJ + SEG_BYTES); const bf16* DZ = (const bf16*)(ws + WS_PROJ + 5 * SEG_BYTES);
    const int gw = F.vcu * NWAVES + F.wave, NGW = F.G * NWAVES;
    const f32x2 nwv = *(const f32x2*)(dn_norm_w + 2 * F.lane);
    for (int m = gw; m < M; m += NGW) {
#pragma unroll 1
        for (int h = 0; h < NH; ++h) { const size_t off = (size_t)m * 512 + h * HD + 2 * F.lane; const f32x2 o = *(const f32x2*)(O + off);
            const float ss = wave_sum(o.x * o.x + o.y * o.y); const float rstd = 1.0f / sqrtf(ss * (1.f / HD) + EPS); const unsigned z = *(const unsigned*)(DZ + off);
            *(unsigned*)(Y + (size_t)m * DM + DPOOL + h * HD + 2 * F.lane) = pk2(o.x * rstd * nwv.x * bflo(z), o.y * rstd * nwv.y * bfhi(z)); } }
    const int g = blockIdx.x & 3; const int win = 2 << g;
    LAS float* lw = (LAS float*)(F.lds); LAS float* mixb = lw + 128 * 128 + F.wave * 128;
    for (int idx = F.tid; idx < 128 * 128; idx += NWAVES * 64) lw[idx] = pool_w[(size_t)g * 128 * 128 + idx];
    __syncthreads();
    const int wg = (blockIdx.x >> 2) * NWAVES + F.wave, NWG = (F.G >> 2) * NWAVES;
    const float sc0 = pool_scale[g * 128 + F.lane], sc1 = pool_scale[g * 128 + F.lane + 64];
    for (int m = wg; m < M; m += NWG) { const int s = m % SEQ; const int cnt = (s + 1) < win ? (s + 1) : win;
        float s0 = 0.f, s1 = 0.f, u0 = 0.f, u1 = 0.f;
        for (int j = 0; j < cnt; ++j) { const unsigned u = *(const unsigned*)(PU + (size_t)(m - j) * 512 + g * 128 + 2 * F.lane); const float f0 = bflo(u), f1 = bfhi(u); s0 += f0; s1 += f1; if (j == 0) { u0 = f0; u1 = f1; } }
        const float inv = 1.0f / (float)cnt;
        mixb[2 * F.lane] = s0 * inv - u0; mixb[2 * F.lane + 1] = s1 * inv - u1;
        asm volatile("s_waitcnt lgkmcnt(0)" ::: "memory");
        float acc0 = 0.f, acc1 = 0.f;
#pragma unroll 8
        for (int c = 0; c < 128; ++c) { const float mv = mixb[c]; acc0 += mv * lw[c * 128 + F.lane]; acc1 += mv * lw[c * 128 + F.lane + 64]; }
        asm volatile("s_waitcnt lgkmcnt(0)" ::: "memory");
        const float z0 = bf2f(PZ[(size_t)m * 512 + g * 128 + F.lane]), z1 = bf2f(PZ[(size_t)m * 512 + g * 128 + F.lane + 64]);
        Y[(size_t)m * DM + g * 128 + F.lane] = (bf16)f2bf(acc0 * sc0 * z0); Y[(size_t)m * DM + g * 128 + F.lane + 64] = (bf16)f2bf(acc1 * sc1 * z1); }
}

__device__ __forceinline__ void p6_final_norm(Frame& F, const Args& A) {
    const float* fw = A.in[10]; float* out = A.out;
    const int gw = F.vcu * NWAVES + F.wave, NGW = F.G * NWAVES;
    f32x4 nw[4];
#pragma unroll
    for (int j = 0; j < 4; ++j) nw[j] = *(const f32x4*)(fw + 4 * F.lane + 256 * j);
    for (int m = gw; m < M; m += NGW) {
        GAS f32x4* xr = (GAS f32x4*)(out + (size_t)m * DM) + F.lane;
        f32x4 v[4]; float s2 = 0.f;
#pragma unroll
        for (int j = 0; j < 4; ++j) { v[j] = xr[64 * j]; s2 += (v[j].x * v[j].x + v[j].y * v[j].y) + (v[j].z * v[j].z + v[j].w * v[j].w); }
        const float rstd = 1.0f / sqrtf(wave_sum(s2) * (1.f / DM) + EPS);
#pragma unroll
        for (int j = 0; j < 4; ++j) xr[64 * j] = v[j] * rstd * nw[j];
    }
}

__global__ void __launch_bounds__(NWAVES * 64, 2) fwd(Args args) {
    extern __shared__ __attribute__((aligned(16))) unsigned char lds[];
    Frame F;
    F.lds = (LAS unsigned char*)lds;
    F.MISC = (volatile LAS unsigned*)(F.lds + MISC_OFF);
    F.tid = threadIdx.x; F.lane = F.tid & 63; F.wave = __builtin_amdgcn_readfirstlane(F.tid >> 6);
    F.G = gridDim.x; { const int bx = blockIdx.x; F.vcu = (F.G % 8 == 0) ? (bx % 8) * (F.G / 8) + bx / 8 : bx; }
    unsigned char* ws = args.ws;
    F.ctl = (gu32*)(ws + WS_CTL);
    for (int u = F.tid; u < (LDS_BYTES - LDSCTL_OFF) / 4; u += NWAVES * 64) ((LAS unsigned*)(F.lds + LDSCTL_OFF))[u] = 0u;
    __syncthreads();
    XcdBarrier bar; bar.bar = (unsigned*)(F.ctl + CW_BAR); bar.x = 0; bar.st = nullptr;
    if (N_LAUNCHES == 1) bar = xcd_barrier_post((unsigned*)(F.ctl + CW_BAR), F.MISC + 8);
    const int lo = args.ph_lo, hi = args.ph_hi;
#define IN(k) (lo <= (k) && (k) < hi)
#define BOTH(k) (IN(k) && IN((k) + 1))
#define GRID_BAR() do { xcd_barrier(bar); } while (0)

    if (IN(0)) { p0_prologue(F, args); if (BOTH(0)) GRID_BAR(); }
    if (IN(1)) {
        pg8::Gemm g{(const pg8::bf16_t*)(ws + WS_XN), (const pg8::bf16_t*)(ws + WS_WIN), M, NPROJ, DM}; pg8::StaticOrder S; S.init(M, NPROJ, F.G, (int)blockIdx.x);
        pg8::EpiProj E{(pg8::bf16_t*)(ws + WS_PROJ), SEG_BYTES / 2};
        pg8::gemm_phase<pg8::EpiProj, pg8::StaticOrder, true, true>(F.lds + RING_OFF, g, S, E);
        if (BOTH(1)) GRID_BAR();
    }
    if (IN(2)) { p2_naive(F, args); if (BOTH(2)) GRID_BAR(); }
    if (IN(3)) { p3_naive(F, args); if (BOTH(3)) GRID_BAR(); }
    if (IN(4)) { p4_naive(F, args); if (BOTH(4)) GRID_BAR(); }
    if (IN(5)) {
        pg8::Gemm g{(const pg8::bf16_t*)(ws + WS_Y), (const pg8::bf16_t*)(ws + WS_WOUT), M, DM, DM}; pg8::StaticOrder S; S.init(M, DM, F.G, (int)blockIdx.x);
        pg8::EpiResF32 E{args.in[0], args.out, DM};
        pg8::gemm_phase<pg8::EpiResF32, pg8::StaticOrder, true, true>(F.lds + RING_OFF, g, S, E);
        if (BOTH(5)) GRID_BAR();
    }
    if (IN(6)) { p6_final_norm(F, args); }
#undef IN
#undef BOTH
}

extern "C" void kernel_launch(void* const* d_in, const int* in_sizes, int n_in, void* d_out, int out_size, void* d_ws, size_t ws_size, hipStream_t stream) {
    static int grid = 0;
    if (grid == 0) {
        if (n_in != 11 || in_sizes[0] != M * DM || out_size != M * DM || ws_size < WS_END) { fprintf(stderr, "kernel_launch: unexpected shapes: n_in %d in0 %d out %d ws %zu\n", n_in, n_in > 0 ? in_sizes[0] : -1, out_size, ws_size); grid = -1; return; }
        int dev = 0, cus = 0, per_cu = 0;
        if (hipGetDevice(&dev) != hipSuccess || hipDeviceGetAttribute(&cus, hipDeviceAttributeMultiprocessorCount, dev) != hipSuccess) { grid = -1; return; }
        if (hipFuncSetAttribute((const void*)fwd, hipFuncAttributeMaxDynamicSharedMemorySize, LDS_BYTES) != hipSuccess) { fprintf(stderr, "kernel_launch: hipFuncSetAttribute failed\n"); grid = -1; return; }
        if (hipOccupancyMaxActiveBlocksPerMultiprocessor(&per_cu, (const void*)fwd, NWAVES * 64, LDS_BYTES) != hipSuccess || per_cu < 1) fprintf(stderr, "kernel_launch: occupancy query reports %d\n", per_cu);
        (void)hipGetLastError();
        grid = cus;
    }
    if (grid < 0) return;
    if (hipMemsetAsync((char*)d_ws + WS_CTL, 0, CTL_ZERO_BYTES, stream) != hipSuccess) return;
    Args a{};
    for (int i = 0; i < 11; ++i) a.in[i] = (const float*)d_in[i];
    a.out = (float*)d_out; a.ws = (unsigned char*)d_ws;
    for (int li = 0; li < N_LAUNCHES; ++li) {
        a.ph_lo = (N_LAUNCHES == 1) ? 0 : li; a.ph_hi = (N_LAUNCHES == 1) ? N_PHASES : li + 1;
        hipLaunchKernelGGL(fwd, dim3(grid), dim3(NWAVES * 64), LDS_BYTES, stream, a);
        if (hipPeekAtLastError() != hipSuccess) { fprintf(stderr, "kernel_launch: launch %d failed\n", li); break; }
    }
}
```

```cpp
#include <hip/hip_runtime.h>
#include <cstdio>
#include <cstdint>
namespace pg8 {
#define PG8_LAS __attribute__((address_space(3)))
typedef unsigned short bf16_t;
typedef short bf16x8 __attribute__((ext_vector_type(8)));
typedef float f32x4 __attribute__((ext_vector_type(4)));
typedef unsigned u32x4 __attribute__((ext_vector_type(4)));
constexpr int BM = 256, BK = 64, HALF = 128, HTB = HALF * BK * 2  , STAGE_BYTES = 8 * HTB, NXCD = 8, WGM = 8;

__host__ __device__ __forceinline__ int lds_byte(int r, int c) { const int st = (r >> 4) * 2 + (c >> 5), rr = r & 15, cc = c & 31, ob = rr * 64 + cc * 2; return st * 1024 + (ob ^ (((ob >> 9) & 1) << 5)); }
__host__ __device__ __forceinline__ void stage_rc(int b, int& R, int& C) { const int st = b / 1024, sb = b % 1024, swz = sb ^ (((sb >> 9) & 1) << 5); R = (st >> 1) * 16 + swz / 64; C = (st & 1) * 32 + (swz % 64) / 2; }
__host__ __device__ __forceinline__ int perm32(int rho) { const int n = rho >> 4, i = rho & 15; return 8 * (i >> 2) + 4 * n + (i & 3); }

struct Unit { int pm, pn; };
struct Gemm { const bf16_t* A; const bf16_t* Bt; int M, N, K; };

struct StaticOrder {
    int nM, nN, nwg, G, c;
    __host__ __device__ void init(int M, int N, int G_, int c_) { nM = M / BM; nN = N / BM; nwg = nM * nN; G = G_; c = c_; }
    __host__ __device__ bool next(int i, Unit& u) const {
        const long L = (long)i * G + c; if (L >= nwg) return false;
        int wgid = (int)L; { const int q = nwg / NXCD, r = nwg % NXCD, xcd = wgid % NXCD, off = wgid / NXCD; wgid = (xcd < r ? xcd * (q + 1) : r * (q + 1) + (xcd - r) * q) + off; }
        const int nig = WGM * nN, gid = wgid / nig, fm = gid * WGM, gsz = (nM - fm) < WGM ? (nM - fm) : WGM;
        u.pm = fm + ((wgid % nig) % gsz); u.pn = (wgid % nig) / gsz; return true;
    }
    __device__ __forceinline__ void a_ready(const Unit&) const {}
    __device__ __forceinline__ void done(const Unit&) const {}
};

typedef float f32x2 __attribute__((ext_vector_type(2)));
typedef __bf16 bf16x2v __attribute__((ext_vector_type(2)));
__device__ __forceinline__ unsigned cvt_pk_bf16(float lo, float hi) { const bf16x2v v = __builtin_convertvector((f32x2){lo, hi}, bf16x2v); return __builtin_bit_cast(unsigned, v); }
__device__ __forceinline__ float silu_f(float v) { return v * __builtin_amdgcn_rcpf(1.0f + __builtin_amdgcn_exp2f(v * -1.4426950408889634f)); }

struct EpiProj {
    static constexpr bool PERM = true, AFTER_DRAIN = false;
    bf16_t* O; size_t seg_stride;
    __device__ __forceinline__ void operator()(const f32x4 (&acc)[2][2][4][2], const Unit& u, int wr, int wc, int fr, int fq) const {
        const int row0 = u.pm * BM + wr * 64 + fr; const int colt0 = u.pn * BM; const int t = colt0 / 512; const int colt = colt0 - t * 512;
        bf16_t* base = O + (size_t)t * seg_stride; const bool act = (t == 1) || (t == 5);
        const int col0 = colt + wc * 32 + 8 * fq;
#pragma unroll
        for (int ai = 0; ai < 2; ++ai)
#pragma unroll
            for (int m = 0; m < 4; ++m) { bf16_t* rowp = base + (size_t)(row0 + ai * HALF + m * 16) * 512 + col0;
#pragma unroll
                for (int bj = 0; bj < 2; ++bj) { f32x4 v0 = acc[ai][bj][m][0], v1 = acc[ai][bj][m][1];
                    if (act) {
#pragma unroll
                        for (int e = 0; e < 4; ++e) { v0[e] = silu_f(v0[e]); v1[e] = silu_f(v1[e]); } }
                    u32x4 w; w.x = cvt_pk_bf16(v0[0], v0[1]); w.y = cvt_pk_bf16(v0[2], v0[3]); w.z = cvt_pk_bf16(v1[0], v1[1]); w.w = cvt_pk_bf16(v1[2], v1[3]);
                    *(u32x4*)(rowp + bj * HALF) = w; } }
    }
};

struct EpiResF32 {
    static constexpr bool PERM = false, AFTER_DRAIN = false;
    const float* base; float* C; int ldc;
    __device__ __forceinline__ void operator()(const f32x4 (&acc)[2][2][4][2], const Unit& u, int wr, int wc, int fr, int fq) const {
        const int row0 = u.pm * BM + wr * 64 + fr, col0 = u.pn * BM + wc * 32 + 4 * fq;
#pragma unroll
        for (int ai = 0; ai < 2; ++ai)
#pragma unroll
            for (int m = 0; m < 4; ++m) { const size_t off = (size_t)(row0 + ai * HALF + m * 16) * ldc + col0;
#pragma unroll
                for (int bj = 0; bj < 2; ++bj)
#pragma unroll
                    for (int n = 0; n < 2; ++n) *(f32x4*)(C + off + bj * HALF + n * 16) = *(const f32x4*)(base + off + bj * HALF + n * 16) + acc[ai][bj][m][n]; }
    }
};
template <class Epi, class Sched, bool ALIGN_EPI = false, bool SP2 = false>
__device__ __forceinline__ void gemm_phase(PG8_LAS unsigned char* lds, const Gemm g, const Sched& S, const Epi& E) {
    const int tid = threadIdx.x, wid = __builtin_amdgcn_readfirstlane(tid >> 6), lane = tid & 63, wr = wid >> 2, wc = wid & 3, fr = lane & 15, fq = lane >> 4;
    const int K = g.K, nt = K / BK;
    unsigned voffA[2], voffB[2];
#pragma unroll
    for (int i = 0; i < 2; ++i) { int R, C; stage_rc(tid * 16 + i * 8192, R, C); const int Rb = Epi::PERM ? ((R & ~31) + perm32(R & 31)) : R;
        voffA[i] = (unsigned)(R * K + C) * 2u; voffB[i] = (unsigned)(Rb * K + C) * 2u; }
    const size_t kstep = (size_t)(BK * 2);
    const size_t hstep = (size_t)HALF * K * 2;
    const size_t tstep = 2 * hstep;
    const unsigned ldsw = (unsigned)wid * 1024u;
    const int aoff = lds_byte(wr * 64 + fr, fq * 8), boff = lds_byte(wc * 32 + fr, fq * 8);
#define PG8_SA(b, h) (((b) * 2 + (h)) * HTB)
#define PG8_SB(b, h) ((4 + (b) * 2 + (h)) * HTB)
#define PG8_STAGE(bufoff, gbase, voff) do { _Pragma("unroll") for (int _i = 0; _i < 2; ++_i) \
        __builtin_amdgcn_global_load_lds((const unsigned*)((const char*)(gbase) + (voff)[_i]), (PG8_LAS unsigned*)(lds + (bufoff) + ldsw + _i * 8192), 16, 0, 0); } while (0)
#define PG8_LDA(dst, b, h) do { _Pragma("unroll") for (int m = 0; m < 4; ++m) _Pragma("unroll") for (int k = 0; k < 2; ++k) dst[m][k] = *(const PG8_LAS bf16x8*)(lds + PG8_SA(b, h) + aoff + m * 2048 + k * 1024); } while (0)
#define PG8_LDB(dst, b, h) do { _Pragma("unroll") for (int n = 0; n < 2; ++n) _Pragma("unroll") for (int k = 0; k < 2; ++k) dst[n][k] = *(const PG8_LAS bf16x8*)(lds + PG8_SB(b, h) + boff + n * 2048 + k * 1024); } while (0)
#define PG8_MMA(ai, bj, At, Bt) do { __builtin_amdgcn_s_setprio(1); _Pragma("unroll") for (int m = 0; m < 4; ++m) _Pragma("unroll") for (int n = 0; n < 2; ++n) _Pragma("unroll") for (int k = 0; k < 2; ++k) \
        acc[ai][bj][m][n] = __builtin_amdgcn_mfma_f32_16x16x32_bf16(Bt[n][k], At[m][k], acc[ai][bj][m][n], 0, 0, 0); __builtin_amdgcn_s_setprio(0); } while (0)
#define PG8_WAIT_V(n) asm volatile("s_waitcnt vmcnt(" #n ")" ::: "memory")
#define PG8_WAIT_L(n) asm volatile("s_waitcnt lgkmcnt(" #n ")" ::: "memory")
#define PG8_BAR __builtin_amdgcn_s_barrier()
#define PG8_SCHED __builtin_amdgcn_sched_barrier(0)
    Unit cur, nxt; int ui = 0;
    if (!S.next(0, cur)) return;
    f32x4 acc[2][2][4][2];
#pragma unroll
    for (int a = 0; a < 2; ++a)
#pragma unroll
        for (int b = 0; b < 2; ++b)
#pragma unroll
            for (int m = 0; m < 4; ++m)
#pragma unroll
                for (int n = 0; n < 2; ++n) acc[a][b][m][n] = (f32x4){0.f, 0.f, 0.f, 0.f};
    bf16x8 At[4][2], B0[2][2], B1[2][2];
    const char* cA = (const char*)g.A + (size_t)cur.pm * tstep; const char* cB = (const char*)g.Bt + (size_t)cur.pn * tstep;
    S.a_ready(cur);
    if constexpr (SP2) {
        PG8_STAGE(PG8_SB(0, 0), cB, voffB); PG8_STAGE(PG8_SB(0, 1), cB + hstep, voffB); PG8_STAGE(PG8_SA(0, 0), cA, voffA); PG8_STAGE(PG8_SA(0, 1), cA + hstep, voffA);
        if (wr == 1) PG8_BAR;
        PG8_WAIT_V(2); PG8_BAR;
        PG8_STAGE(PG8_SB(1, 0), cB + kstep, voffB); PG8_STAGE(PG8_SA(1, 0), cA + kstep, voffA); PG8_STAGE(PG8_SB(1, 1), cB + hstep + kstep, voffB);
        PG8_WAIT_V(6); PG8_BAR;
    } else {
        PG8_STAGE(PG8_SB(0, 0), cB, voffB); PG8_STAGE(PG8_SA(0, 0), cA, voffA); PG8_STAGE(PG8_SB(0, 1), cB + hstep, voffB); PG8_STAGE(PG8_SA(0, 1), cA + hstep, voffA);
        if (wr == 1) PG8_BAR;
        PG8_WAIT_V(4); PG8_BAR;
        PG8_STAGE(PG8_SB(1, 0), cB + kstep, voffB); PG8_STAGE(PG8_SA(1, 0), cA + kstep, voffA); PG8_STAGE(PG8_SB(1, 1), cB + hstep + kstep, voffB);
        PG8_WAIT_V(6); PG8_BAR;
    }
    for (;;) {
        const bool has_next = S.next(ui + 1, nxt);
        const char* nA = has_next ? (const char*)g.A + (size_t)nxt.pm * tstep : cA; const char* nB = has_next ? (const char*)g.Bt + (size_t)nxt.pn * tstep : cB;
        for (int t = 0; t < nt; t += 2) {
            const bool last = (t == nt - 2);
            const char* a1 = cA + (size_t)(t + 1) * kstep;
            const char* a2 = last ? nA : cA + (size_t)(t + 2) * kstep; const char* b2 = last ? nB : cB + (size_t)(t + 2) * kstep;
            const char* a3 = a2 + kstep; const char* b3 = b2 + kstep;
            if (last && has_next) S.a_ready(nxt);
            if constexpr (SP2) {
            PG8_LDB(B0, 0, 0); PG8_LDB(B1, 0, 1); PG8_SCHED; PG8_LDA(At, 0, 0); PG8_STAGE(PG8_SA(1, 1), a1 + hstep, voffA);
            PG8_WAIT_V(8); PG8_WAIT_L(0); PG8_BAR; PG8_MMA(0, 0, At, B0); PG8_MMA(0, 1, At, B1); PG8_BAR; PG8_SCHED;
            PG8_LDA(At, 0, 1); PG8_STAGE(PG8_SB(0, 0), b2, voffB); PG8_STAGE(PG8_SB(0, 1), b2 + hstep, voffB); PG8_STAGE(PG8_SA(0, 0), a2, voffA);
            PG8_WAIT_V(8); PG8_WAIT_L(0); PG8_BAR; PG8_MMA(1, 0, At, B0); PG8_MMA(1, 1, At, B1); PG8_BAR; PG8_SCHED;
            PG8_LDB(B0, 1, 0); PG8_LDB(B1, 1, 1); PG8_SCHED; PG8_LDA(At, 1, 0); PG8_STAGE(PG8_SA(0, 1), a2 + hstep, voffA);
            PG8_WAIT_V(8); PG8_WAIT_L(0); PG8_BAR; PG8_MMA(0, 0, At, B0); PG8_MMA(0, 1, At, B1); PG8_BAR; PG8_SCHED;
            PG8_LDA(At, 1, 1); PG8_STAGE(PG8_SB(1, 0), b3, voffB); PG8_STAGE(PG8_SB(1, 1), b3 + hstep, voffB); PG8_STAGE(PG8_SA(1, 0), a3, voffA);
            PG8_WAIT_V(8); PG8_WAIT_L(0); PG8_BAR; PG8_MMA(1, 0, At, B0); PG8_MMA(1, 1, At, B1); PG8_BAR; PG8_SCHED;
            } else {
            PG8_LDB(B0, 0, 0); PG8_SCHED; PG8_LDA(At, 0, 0); PG8_STAGE(PG8_SA(1, 1), a1 + hstep, voffA);
            PG8_WAIT_L(8); PG8_BAR; PG8_WAIT_L(0); PG8_MMA(0, 0, At, B0); PG8_BAR; PG8_SCHED;
            PG8_LDB(B1, 0, 1); PG8_STAGE(PG8_SB(0, 0), b2, voffB);
            PG8_BAR; PG8_WAIT_L(0); PG8_MMA(0, 1, At, B1); PG8_BAR;
            PG8_LDA(At, 0, 1); PG8_STAGE(PG8_SA(0, 0), a2, voffA);
            PG8_BAR; PG8_WAIT_L(0); PG8_MMA(1, 0, At, B0); PG8_BAR; PG8_SCHED;
            PG8_STAGE(PG8_SB(0, 1), b2 + hstep, voffB);
            PG8_WAIT_V(6); PG8_BAR; PG8_MMA(1, 1, At, B1); PG8_BAR;
            PG8_LDB(B0, 1, 0); PG8_SCHED; PG8_LDA(At, 1, 0); PG8_STAGE(PG8_SA(0, 1), a2 + hstep, voffA);
            PG8_WAIT_L(8); PG8_BAR; PG8_WAIT_L(0); PG8_MMA(0, 0, At, B0); PG8_BAR; PG8_SCHED;
            PG8_LDB(B1, 1, 1); PG8_STAGE(PG8_SB(1, 0), b3, voffB);
            PG8_BAR; PG8_WAIT_L(0); PG8_MMA(0, 1, At, B1); PG8_BAR;
            PG8_LDA(At, 1, 1); PG8_STAGE(PG8_SA(1, 0), a3, voffA);
            PG8_BAR; PG8_WAIT_L(0); PG8_MMA(1, 0, At, B0); PG8_BAR; PG8_SCHED;
            PG8_STAGE(PG8_SB(1, 1), b3 + hstep, voffB);
            PG8_WAIT_V(6); PG8_BAR; PG8_MMA(1, 1, At, B1); PG8_BAR;
            }
        }
        if constexpr (ALIGN_EPI) { if (wr == 0) PG8_BAR; }
        if constexpr (!Epi::AFTER_DRAIN) { E(acc, cur, wr, wc, fr, fq); S.done(cur); }
        if (!has_next) break;
#pragma unroll
        for (int a = 0; a < 2; ++a)
#pragma unroll
            for (int b = 0; b < 2; ++b)
#pragma unroll
                for (int m = 0; m < 4; ++m)
#pragma unroll
                    for (int n = 0; n < 2; ++n) acc[a][b][m][n] = (f32x4){0.f, 0.f, 0.f, 0.f};
        cur = nxt; cA = nA; cB = nB; ++ui;
        if constexpr (ALIGN_EPI) { if (wr == 1) PG8_BAR; }
    }
    PG8_WAIT_V(0);
    if constexpr (!ALIGN_EPI) { if (wr == 0) PG8_BAR; }
    PG8_BAR;
    if constexpr (Epi::AFTER_DRAIN) { E.fused(acc, cur, wr, wc, fr, fq, lds, wid, lane); S.done(cur); }
#undef PG8_SA
#undef PG8_SB
#undef PG8_STAGE
#undef PG8_LDA
#undef PG8_LDB
#undef PG8_MMA
#undef PG8_WAIT_V
#undef PG8_WAIT_L
#undef PG8_BAR
#undef PG8_SCHED
}
}
#define GAS __attribute__((address_space(1)))
#define LAS __attribute__((address_space(3)))
typedef unsigned short bf16;
typedef unsigned v4u __attribute__((ext_vector_type(4)));
typedef float f32x4 __attribute__((ext_vector_type(4)));
typedef short bf16x8 __attribute__((ext_vector_type(8)));
typedef GAS unsigned gu32;
typedef GAS unsigned long long gu64;
#define RLX_AGENT __ATOMIC_RELAXED, __HIP_MEMORY_SCOPE_AGENT
#define LDS_WAIT() asm volatile("s_waitcnt lgkmcnt(0)" ::: "memory")
#define VM_WAIT() asm volatile("s_waitcnt vmcnt(0)" ::: "memory")
__device__ __forceinline__ unsigned long long rt() { return __builtin_amdgcn_s_memrealtime(); }
__device__ __forceinline__ unsigned f2bf(float f) { unsigned u = __builtin_bit_cast(unsigned, f); return (u + 0x7fffu + ((u >> 16) & 1u)) >> 16; }
__device__ __forceinline__ unsigned pk2(float lo, float hi) { return f2bf(lo) | (f2bf(hi) << 16); }

#define XB_TMO      128
#define XB_XCNT(j)  (256  + 64 * (j))
#define XB_XSUB(j)  (1280 + 64 * (j))
#define XB_XGEN(j)  (2304 + 64 * (j))
#define XB_TOP      3328
#define XB_TOPGEN   3392
#define XCD_BAR_WORDS 3456
#define XB_SPIN_CAP (1u << 18)

__device__ __forceinline__ unsigned xb_ld(unsigned* p)              { return __hip_atomic_load(p, __ATOMIC_RELAXED, __HIP_MEMORY_SCOPE_AGENT); }
__device__ __forceinline__ unsigned xb_add(unsigned* p, unsigned v) { return __hip_atomic_fetch_add(p, v, __ATOMIC_RELAXED, __HIP_MEMORY_SCOPE_AGENT); }
__device__ __forceinline__ unsigned xb_xcc_id() { return (unsigned)__builtin_amdgcn_s_getreg((3 << 11) | 20) & 0xFu; }
#define XB_SPIN(cond, bar) do { unsigned _sp = 0; while (cond) { __builtin_amdgcn_s_sleep(1); \
    if ((++_sp & 255u) == 0u) { if (xb_ld(&(bar)[XB_TMO])) break; if (_sp > XB_SPIN_CAP) { atomicAdd(&(bar)[XB_TMO], 1u); break; } } } } while (0)

struct XcdBarrier {
    unsigned* bar; unsigned x;
    volatile LAS unsigned* st;
};

__device__ __forceinline__ XcdBarrier xcd_barrier_post(unsigned* bar, volatile LAS unsigned* st) {
    XcdBarrier b; b.bar = bar; b.x = xb_xcc_id(); b.st = st;
    if (threadIdx.x == 0) (void)xb_add(&bar[XB_XCNT(b.x)], 1u);
    return b;
}
__device__ __forceinline__ void xcd_barrier_complete(unsigned* bar, unsigned x, unsigned& nloc, unsigned& nx) {
    const unsigned G = gridDim.x * gridDim.y * gridDim.z;
    unsigned sum, cnt, mine, sp = 0u;
    for (;;) {
        sum = 0u; cnt = 0u; mine = 0u;
#pragma unroll
        for (unsigned j = 0; j < 16; ++j) { const unsigned c = xb_ld(&bar[XB_XCNT(j)]); sum += c; cnt += (c > 0u) ? 1u : 0u; mine = (j == x) ? c : mine; }
        if (sum == G) break;
        __builtin_amdgcn_s_sleep(1);
        if ((++sp & 255u) == 0u) { if (xb_ld(&bar[XB_TMO])) break; if (sp > XB_SPIN_CAP) { atomicAdd(&bar[XB_TMO], 1u); break; } }
    }
    nloc = mine > 0u ? mine : 1u; nx = cnt > 0u ? cnt : 1u;
}

__device__ __forceinline__ void xcd_barrier(const XcdBarrier& b) {
    asm volatile("s_waitcnt vmcnt(0)" ::: "memory");
    __syncthreads();
    if (threadIdx.x == 0) {
        unsigned* bar = b.bar;
        __builtin_amdgcn_s_waitcnt(0);
        unsigned nloc = b.st[0], nx = b.st[1];
        if (nloc == 0u) { xcd_barrier_complete(bar, b.x, nloc, nx); b.st[0] = nloc; b.st[1] = nx; }
        const unsigned old = xb_add(&bar[XB_XSUB(b.x)], 1u);
        const unsigned gen = old / nloc;
        if (old + 1u == (gen + 1u) * nloc) {
            __builtin_amdgcn_fence(__ATOMIC_RELEASE, "agent");
            asm volatile("s_waitcnt vmcnt(0)" ::: "memory");
            const unsigned og = xb_add(&bar[XB_TOP], 1u);
            const unsigned tg = og / nx;
            if (og + 1u == (tg + 1u) * nx) xb_add(&bar[XB_TOPGEN], 1u);
            else XB_SPIN(xb_ld(&bar[XB_TOPGEN]) == tg, bar);
            __builtin_amdgcn_fence(__ATOMIC_ACQUIRE, "agent");
            xb_add(&bar[XB_XGEN(b.x)], 1u);
            asm volatile("s_waitcnt vmcnt(0)" ::: "memory");
        } else {
            XB_SPIN(xb_ld(&bar[XB_XGEN(b.x)]) == gen, bar);
            __builtin_amdgcn_fence(__ATOMIC_ACQUIRE, "agent");
            asm volatile("s_waitcnt vmcnt(0)" ::: "memory");
        }
    }
    __syncthreads();
}
typedef float f32x2 __attribute__((ext_vector_type(2)));

constexpr int NWAVES = 8;
#ifndef MK_N_LAUNCHES
#define MK_N_LAUNCHES 1
#endif
constexpr int N_LAUNCHES = MK_N_LAUNCHES;
constexpr int N_PHASES = 7;
constexpr int BATCH = 8, SEQ = 4096, DM = 1024, M = BATCH * SEQ;
constexpr int DIN = 3080, NPROJ = 3072, NH = 4, HD = 128, DDN = 512, DPOOL = 512, NSEG = 6;
constexpr float EPS = 1e-6f;
constexpr size_t MiB = 1u << 20;
constexpr size_t WS_CTL = 0, CTL_ZERO_BYTES = 1 * MiB;
constexpr size_t WS_WIN = 2 * MiB, WS_WOUT = 8 * MiB;
constexpr size_t WS_BETA = 10 * MiB, WS_G = 10 * MiB + 512 * 1024;
constexpr size_t WS_PROJ = 16 * MiB, SEG_BYTES = 32 * MiB;
constexpr size_t WS_XN = 208 * MiB;
constexpr size_t WS_DEC = 11 * MiB;
constexpr size_t WS_CH = 272 * MiB;
constexpr size_t WS_O = 464 * MiB;
constexpr size_t WS_Y = 80 * MiB;
constexpr size_t WS_END = 496 * MiB;
constexpr int CW_BAR = 4096;
constexpr int RING_OFF = 0, RING_BYTES = 131072;
constexpr int LDS_BYTES = 163840;
constexpr int LDSCTL_OFF = LDS_BYTES - 1024, MISC_OFF = LDSCTL_OFF + 320;

struct Frame {
    LAS unsigned char* lds;
    volatile LAS unsigned* MISC;
    gu32* ctl;
    int tid, lane, wave, vcu, G;
};
__device__ __forceinline__ float wave_sum(float v) {
#pragma unroll
    for (int o = 1; o < 64; o <<= 1) v += __shfl_xor(v, o);
    return v;
}
__device__ __forceinline__ float bf2f(unsigned short u) { return __uint_as_float((unsigned)u << 16); }
__device__ __forceinline__ float bflo(unsigned u) { return __uint_as_float(u << 16); }
__device__ __forceinline__ float bfhi(unsigned u) { return __uint_as_float(u & 0xffff0000u); }
__device__ __forceinline__ float silu(float v) { return v / (1.0f + __expf(-v)); }

__device__ __forceinline__ void p0_transpose_item(const float* W, int K, int ldw, int nblk, bf16* WT, LAS float* scr, int item, int lane) {
    const int kb = item / nblk, nb = item % nblk, k0 = 64 * kb, n0 = 32 * nb;
#pragma unroll 8
    for (int i = 0; i < 32; ++i) { const int kk = 2 * i + (lane >> 5); scr[kk * 33 + (lane & 31)] = W[(size_t)(k0 + kk) * ldw + n0 + (lane & 31)]; }
    LDS_WAIT(); asm volatile("" ::: "memory");
    const int c = lane & 7;
#pragma unroll
    for (int j = 0; j < 4; ++j) { const int n = (lane >> 3) + 8 * j; const LAS float* s = scr + (8 * c) * 33 + n;
        v4u o; o.x = pk2(s[0 * 33], s[1 * 33]); o.y = pk2(s[2 * 33], s[3 * 33]); o.z = pk2(s[4 * 33], s[5 * 33]); o.w = pk2(s[6 * 33], s[7 * 33]);
        *(GAS v4u*)(WT + (size_t)(n0 + n) * K + k0 + 8 * c) = o; }
    LDS_WAIT(); asm volatile("" ::: "memory");
}

struct Args { const float* in[11]; float* out; unsigned char* ws; int ph_lo, ph_hi; };

__device__ __forceinline__ void p0_prologue(Frame& F, const Args& A) {
    unsigned char* ws = A.ws;
    const float* x = A.in[0]; const float* norm_w = A.in[1]; const float* w_in = A.in[2]; const float* a_log = A.in[6]; const float* dt_bias = A.in[7]; const float* w_out = A.in[9];
    bf16* win_t = (bf16*)(ws + WS_WIN); bf16* wout_t = (bf16*)(ws + WS_WOUT); bf16* XN = (bf16*)(ws + WS_XN);
    float* beta = (float*)(ws + WS_BETA); float* gg = (float*)(ws + WS_G);
    LAS float* scr = (LAS float*)(F.lds + RING_OFF + F.wave * 16384);
    const int gw = F.vcu * NWAVES + F.wave, NGW = F.G * NWAVES;
    constexpr int I_IN = (DM / 64) * (NPROJ / 32), I_OUT = (DM / 64) * (DM / 32);
    for (int it = gw; it < I_IN + I_OUT; it += NGW) {
        if (it < I_IN) p0_transpose_item(w_in, DM, DIN, NPROJ / 32, win_t, scr, it, F.lane);
        else p0_transpose_item(w_out, DM, DM, DM / 32, wout_t, scr, it - I_IN, F.lane);
    }
    f32x4 nw[4];
#pragma unroll
    for (int j = 0; j < 4; ++j) nw[j] = *(const f32x4*)(norm_w + 4 * F.lane + 256 * j);
    float alog[4], dtb[4];
#pragma unroll
    for (int h = 0; h < 4; ++h) { alog[h] = a_log[h]; dtb[h] = dt_bias[h]; }
    for (int m = gw; m < M; m += NGW) {
        const GAS f32x4* xr = (const GAS f32x4*)(x + (size_t)m * DM) + F.lane;
        f32x4 v[4]; float s2 = 0.f;
#pragma unroll
        for (int j = 0; j < 4; ++j) { v[j] = xr[64 * j]; s2 += (v[j].x * v[j].x + v[j].y * v[j].y) + (v[j].z * v[j].z + v[j].w * v[j].w); }
        const float rstd = 1.0f / sqrtf(wave_sum(s2) * (1.f / DM) + EPS);
#pragma unroll
        for (int j = 0; j < 4; ++j) v[j] = v[j] * rstd * nw[j];
        GAS unsigned long long* o8 = (GAS unsigned long long*)(XN + (size_t)m * DM) + F.lane;
#pragma unroll
        for (int j = 0; j < 4; ++j) o8[64 * j] = (unsigned long long)pk2(v[j].x, v[j].y) | ((unsigned long long)pk2(v[j].z, v[j].w) << 32);
        float ga[8];
#pragma unroll
        for (int c = 0; c < 8; ++c) ga[c] = 0.f;
#pragma unroll
        for (int j = 0; j < 4; ++j)
#pragma unroll
            for (int e = 0; e < 4; ++e) { const int k = 4 * F.lane + 256 * j + e; const f32x4 w0 = *(const f32x4*)(w_in + (size_t)k * DIN + NPROJ), w1 = *(const f32x4*)(w_in + (size_t)k * DIN + NPROJ + 4);
                const float xv = v[j][e];
                ga[0] += xv * w0.x; ga[1] += xv * w0.y; ga[2] += xv * w0.z; ga[3] += xv * w0.w; ga[4] += xv * w1.x; ga[5] += xv * w1.y; ga[6] += xv * w1.z; ga[7] += xv * w1.w; }
#pragma unroll
        for (int c = 0; c < 8; ++c) ga[c] = wave_sum(ga[c]);
        if (F.lane < 4) { const int h = F.lane; const float bl = h == 0 ? ga[0] : h == 1 ? ga[1] : h == 2 ? ga[2] : ga[3]; const float al = h == 0 ? ga[4] : h == 1 ? ga[5] : h == 2 ? ga[6] : ga[7];
            const float al_ = h == 0 ? alog[0] : h == 1 ? alog[1] : h == 2 ? alog[2] : alog[3]; const float db_ = h == 0 ? dtb[0] : h == 1 ? dtb[1] : h == 2 ? dtb[2] : dtb[3];
            const float z = al + db_; const float sp = fmaxf(z, 0.f) + log1pf(__expf(-fabsf(z)));
            beta[(size_t)m * 4 + h] = 1.0f / (1.0f + __expf(-bl)); gg[(size_t)m * 4 + h] = -__expf(al_) * sp; }
    }
}


typedef short bf16x4 __attribute__((ext_vector_type(4)));
#define DBG_T2 0
#define DBG_P2C 0
#define DBG_T1 0
#define MFMA16(a, b, c) __builtin_amdgcn_mfma_f32_16x16x32_bf16((a), (b), (c), 0, 0, 0)
#define MFMAF32(a, b, c) __builtin_amdgcn_mfma_f32_16x16x4f32((a), (b), (c), 0, 0, 0)
constexpr int CH_G = 0, CH_QE = 32768, CH_N = 49152, CH_OL = 81920, CH_BYTES = 98304;
constexpr int L_KR = 0, L_QR = 17408, L_KTD = 34816, L_VBT = 53248, L_KBT = 71680, L_AF = 90112, L_TF = 107520, L_QK = 124928, L_TB = 134144, L_GT = 143360;
constexpr int PK = 272, PT = 144, PA = 272;
__device__ __forceinline__ float rdlane(float v, int l) { return __int_as_float(__builtin_amdgcn_readlane(__float_as_int(v), l)); }
__device__ __forceinline__ unsigned pkbf(float lo, float hi) { return pg8::cvt_pk_bf16(lo, hi); }

__device__ __forceinline__ void p2_unit(Frame& F, const Args& A, const int bh, const int c) {
    LAS unsigned char* L = F.lds; unsigned char* ws = A.ws;
    const int b = bh >> 2, h = bh & 3, w = F.wave; int lane = F.lane; asm volatile("" : "+v"(lane)); int q = lane >> 4, n = lane & 15;
#define P2_FRESH() do { lane = F.lane; asm volatile("" : "+v"(lane)); q = lane >> 4; n = lane & 15; } while (0)
    const size_t m0 = (size_t)b * SEQ + 64 * c;
    const float* conv_w = A.in[5];
    const float* beta = (const float*)(ws + WS_BETA); const float* gg = (const float*)(ws + WS_G);
    unsigned char* rec = ws + WS_CH + (size_t)(bh * 64 + c) * CH_BYTES;
    LAS float* LG = (LAS float*)(L + L_GT); LAS float* LB = LG + 64; LAS float* LE = LG + 128;
    float gc = gg[(m0 + lane) * 4 + h]; const float be_t = beta[(m0 + lane) * 4 + h];
#pragma unroll
    for (int o = 1; o < 64; o <<= 1) { const float t = __shfl_up(gc, o); if (lane >= o) gc += t; }
    const float gl = rdlane(gc, 63);
    const float E_t = __expf(gc), F_t = __expf(gl - gc);
    if (w == 0) { LG[lane] = gc; LB[lane] = be_t; LE[lane] = E_t; if (lane == 0) ((float*)(ws + WS_DEC))[bh * 64 + c] = __expf(gl); }
#pragma unroll 1
    for (int seg = 0; seg < 3; ++seg) {
        const bf16* src = (const bf16*)(ws + WS_PROJ + (size_t)(2 + seg) * SEG_BYTES) + h * HD + 2 * lane;
        unsigned raw[11];
#pragma unroll
        for (int r = 0; r < 11; ++r) { const int tok = 64 * c + 8 * w + r - 3; raw[r] = (tok >= 0) ? *(const unsigned*)(src + (m0 + 8 * w + r - 3) * 512) : 0u; }
        f32x2 cw[4];
#pragma unroll
        for (int j = 0; j < 4; ++j) cw[j] = *(const f32x2*)(conv_w + (size_t)j * 1536 + seg * 512 + h * HD + 2 * lane);
        float a0[8], a1[8];
#pragma unroll
        for (int i = 0; i < 8; ++i) { float x0 = 0.f, x1 = 0.f;
#pragma unroll
            for (int j = 0; j < 4; ++j) { x0 += cw[j].x * bflo(raw[i + j]); x1 += cw[j].y * bfhi(raw[i + j]); }
            a0[i] = silu(x0); a1[i] = silu(x1); }
        if (seg < 2) {
#pragma unroll
            for (int i = 0; i < 8; ++i) { const float ss = wave_sum(a0[i] * a0[i] + a1[i] * a1[i]); float sc = 1.0f / sqrtf(ss + EPS); if (seg == 0) sc *= 0.08838834764831845f; a0[i] *= sc; a1[i] *= sc; } }
        if (seg == 0) {
#pragma unroll
            for (int i = 0; i < 8; ++i) *(LAS unsigned*)(L + L_QR + (8 * w + i) * PK + 4 * lane) = pkbf(a0[i], a1[i]);
        } else if (seg == 1) {
            float kd0[8], kd1[8], kb0[8], kb1[8];
#pragma unroll
            for (int i = 0; i < 8; ++i) { *(LAS unsigned*)(L + L_KR + (8 * w + i) * PK + 4 * lane) = pkbf(a0[i], a1[i]);
                const float fi = __shfl(F_t, 8 * w + i), bi = __shfl(be_t, 8 * w + i) * __shfl(E_t, 8 * w + i);
                kd0[i] = a0[i] * fi; kd1[i] = a1[i] * fi; kb0[i] = a0[i] * bi; kb1[i] = a1[i] * bi; }
            *(LAS v4u*)(L + L_KTD + (2 * lane) * PT + 16 * w) = (v4u){pkbf(kd0[0], kd0[1]), pkbf(kd0[2], kd0[3]), pkbf(kd0[4], kd0[5]), pkbf(kd0[6], kd0[7])};
            *(LAS v4u*)(L + L_KTD + (2 * lane + 1) * PT + 16 * w) = (v4u){pkbf(kd1[0], kd1[1]), pkbf(kd1[2], kd1[3]), pkbf(kd1[4], kd1[5]), pkbf(kd1[6], kd1[7])};
            *(LAS v4u*)(L + L_KBT + (2 * lane) * PT + 16 * w) = (v4u){pkbf(kb0[0], kb0[1]), pkbf(kb0[2], kb0[3]), pkbf(kb0[4], kb0[5]), pkbf(kb0[6], kb0[7])};
            *(LAS v4u*)(L + L_KBT + (2 * lane + 1) * PT + 16 * w) = (v4u){pkbf(kb1[0], kb1[1]), pkbf(kb1[2], kb1[3]), pkbf(kb1[4], kb1[5]), pkbf(kb1[6], kb1[7])};
        } else {
#pragma unroll
            for (int i = 0; i < 8; ++i) { const float bi = __shfl(be_t, 8 * w + i); a0[i] *= bi; a1[i] *= bi; }
            *(LAS v4u*)(L + L_VBT + (2 * lane) * PT + 16 * w) = (v4u){pkbf(a0[0], a0[1]), pkbf(a0[2], a0[3]), pkbf(a0[4], a0[5]), pkbf(a0[6], a0[7])};
            *(LAS v4u*)(L + L_VBT + (2 * lane + 1) * PT + 16 * w) = (v4u){pkbf(a1[0], a1[1]), pkbf(a1[2], a1[3]), pkbf(a1[4], a1[5]), pkbf(a1[6], a1[7])};
        }
    }
    __syncthreads();
    P2_FRESH();
    {
        const int tp = w >> 1, t2 = 2 * (w & 1);
#pragma unroll
        for (int mat = 0; mat < 2; ++mat)
#pragma unroll
            for (int u2 = 0; u2 < 2; ++u2) {
                const int tr = tp, tc = t2 + u2; f32x4 acc = (f32x4){0.f, 0.f, 0.f, 0.f};
#pragma unroll
                for (int s = 0; s < 4; ++s) { const bf16x8 af = *(const LAS bf16x8*)(L + L_KR + (16 * tr + n) * PK + 64 * s + 16 * q);
                    const bf16x8 bfr = *(const LAS bf16x8*)(L + (mat == 0 ? L_KR : L_QR) + (16 * tc + n) * PK + 64 * s + 16 * q); acc = MFMA16(af, bfr, acc); }
                if (mat == 0) { const int j = 16 * tc + n; const float gj = LG[j];
#pragma unroll
                    for (int r = 0; r < 4; ++r) { const int i = 16 * tr + 4 * q + r; const float v = (i > j) ? LB[i] * acc[r] * __expf(LG[i] - gj) : 0.f; *(LAS float*)(L + L_AF + i * PA + 4 * j) = v; }
                } else { const int i = 16 * tc + n; const float gi = LG[i]; float v[4];
#pragma unroll
                    for (int r = 0; r < 4; ++r) { const int j = 16 * tr + 4 * q + r; v[r] = (i >= j) ? acc[r] * __expf(gi - LG[j]) : 0.f; }
                    *(LAS unsigned long long*)(L + L_QK + i * PT + 2 * (16 * tr + 4 * q)) = (unsigned long long)pkbf(v[0], v[1]) | ((unsigned long long)pkbf(v[2], v[3]) << 32); }
            }
    }
    __syncthreads();
    P2_FRESH();
    if (w == 0) { const int bb = q; float t[16];
#pragma unroll
        for (int i = 0; i < 16; ++i) { float v = (i == n) ? 1.f : 0.f; const LAS unsigned char* ar = L + L_AF + (16 * bb + i) * PA + 4 * 16 * bb;
#pragma unroll
            for (int m4 = 0; m4 < (i + 3) / 4; ++m4) { const f32x4 av = *(const LAS f32x4*)(ar + 16 * m4);
#pragma unroll
                for (int e = 0; e < 4; ++e) if (4 * m4 + e < i) v -= av[e] * t[4 * m4 + e]; }
            t[i] = v; __builtin_amdgcn_sched_barrier(0); }
#pragma unroll
        for (int i = 0; i < 16; ++i) { *(LAS float*)(L + L_TF + (16 * bb + i) * PA + 4 * (16 * bb + n)) = t[i];
#pragma unroll
            for (int b2 = 1; b2 < 4; ++b2) if (b2 > bb) *(LAS float*)(L + L_TF + (16 * bb + i) * PA + 4 * (16 * b2 + n)) = 0.f; }
    }
    __syncthreads();
    P2_FRESH();
    if (w < 2) { const int lo = 2 * w, hi = 2 * w + 1; f32x4 y = (f32x4){0.f, 0.f, 0.f, 0.f};
#pragma unroll
        for (int s = 0; s < 4; ++s) { const float a = *(const LAS float*)(L + L_AF + (16 * hi + n) * PA + 4 * (16 * lo + 4 * s + q)); const float bv = *(const LAS float*)(L + L_TF + (16 * lo + 4 * s + q) * PA + 4 * (16 * lo + n)); y = MFMAF32(a, bv, y); }
        f32x4 x = (f32x4){0.f, 0.f, 0.f, 0.f};
#pragma unroll
        for (int s = 0; s < 4; ++s) { const float a = *(const LAS float*)(L + L_TF + (16 * hi + n) * PA + 4 * (16 * hi + 4 * q + s)); x = MFMAF32(a, y[s], x); }
#pragma unroll
        for (int r = 0; r < 4; ++r) *(LAS float*)(L + L_TF + (16 * hi + 4 * q + r) * PA + 4 * (16 * lo + n)) = -x[r];
    }
    __syncthreads();
    P2_FRESH();
    if (w < 2) { const int ct = w; f32x4 y[2];
#pragma unroll
        for (int kb = 0; kb < 2; ++kb) { y[kb] = (f32x4){0.f, 0.f, 0.f, 0.f};
#pragma unroll
            for (int jb = 0; jb < 2; ++jb)
#pragma unroll
                for (int s = 0; s < 4; ++s) { const float a = *(const LAS float*)(L + L_AF + (32 + 16 * kb + n) * PA + 4 * (16 * jb + 4 * s + q)); const float bv = *(const LAS float*)(L + L_TF + (16 * jb + 4 * s + q) * PA + 4 * (16 * ct + n)); y[kb] = MFMAF32(a, bv, y[kb]); } }
#pragma unroll
        for (int rt = 0; rt < 2; ++rt) { f32x4 x = (f32x4){0.f, 0.f, 0.f, 0.f};
#pragma unroll
            for (int kb = 0; kb < 2; ++kb)
#pragma unroll
                for (int s = 0; s < 4; ++s) { const float a = *(const LAS float*)(L + L_TF + (32 + 16 * rt + n) * PA + 4 * (32 + 16 * kb + 4 * q + s)); x = MFMAF32(a, y[kb][s], x); }
#pragma unroll
            for (int r = 0; r < 4; ++r) *(LAS float*)(L + L_TF + (32 + 16 * rt + 4 * q + r) * PA + 4 * (16 * ct + n)) = -x[r]; }
    }
    __syncthreads();
    P2_FRESH();
    { const int i = F.tid >> 3, j0 = 8 * (F.tid & 7); const f32x4 t0 = *(const LAS f32x4*)(L + L_TF + i * PA + 4 * j0), t1 = *(const LAS f32x4*)(L + L_TF + i * PA + 4 * j0 + 16);
        float v[8] = {t0[0], t0[1], t0[2], t0[3], t1[0], t1[1], t1[2], t1[3]};
#pragma unroll
        for (int e = 0; e < 8; ++e) if (j0 + e > i) v[e] = 0.f;
        *(LAS v4u*)(L + L_TB + i * PT + 2 * j0) = (v4u){pkbf(v[0], v[1]), pkbf(v[2], v[3]), pkbf(v[4], v[5]), pkbf(v[6], v[7])}; }
    __syncthreads();
    P2_FRESH();
    f32x4 uacc[4], wacc[4];
    { const int td = w;
#pragma unroll
        for (int ti = 0; ti < 4; ++ti) { uacc[ti] = (f32x4){0.f, 0.f, 0.f, 0.f}; wacc[ti] = (f32x4){0.f, 0.f, 0.f, 0.f};
#pragma unroll
            for (int s = 0; s < 2; ++s) { if (32 * s > 16 * ti + 15) continue;
                const bf16x8 af = *(const LAS bf16x8*)(L + L_TB + (16 * ti + n) * PT + 64 * s + 16 * q);
                const bf16x8 bu = *(const LAS bf16x8*)(L + L_VBT + (16 * td + n) * PT + 64 * s + 16 * q), bw = *(const LAS bf16x8*)(L + L_KBT + (16 * td + n) * PT + 64 * s + 16 * q);
                uacc[ti] = MFMA16(af, bu, uacc[ti]); wacc[ti] = MFMA16(af, bw, wacc[ti]); } } }
    __syncthreads();
    P2_FRESH();
    { const int td = w;
#pragma unroll
        for (int ti = 0; ti < 4; ++ti) {
            *(LAS unsigned long long*)(L + L_VBT + (16 * td + n) * PT + 2 * (16 * ti + 4 * q)) = (unsigned long long)pkbf(uacc[ti][0], uacc[ti][1]) | ((unsigned long long)pkbf(uacc[ti][2], uacc[ti][3]) << 32);
            *(LAS unsigned long long*)(L + L_KBT + (16 * td + n) * PT + 2 * (16 * ti + 4 * q)) = (unsigned long long)pkbf(wacc[ti][0], wacc[ti][1]) | ((unsigned long long)pkbf(wacc[ti][2], wacc[ti][3]) << 32); } }
    __syncthreads();
    P2_FRESH();
    {
        const int td = w;
#pragma unroll
        for (int s2 = 0; s2 < 4; ++s2) { f32x4 acc[2];
#pragma unroll
            for (int hf = 0; hf < 2; ++hf) { const int tdp = 2 * s2 + hf; acc[hf] = (f32x4){0.f, 0.f, 0.f, 0.f};
#pragma unroll
                for (int s = 0; s < 2; ++s) { const bf16x8 af = *(const LAS bf16x8*)(L + L_KBT + (16 * tdp + n) * PT + 64 * s + 16 * q); const bf16x8 bfr = *(const LAS bf16x8*)(L + L_KTD + (16 * td + n) * PT + 64 * s + 16 * q); acc[hf] = MFMA16(af, bfr, acc[hf]); } }
            *(v4u*)(rec + CH_G + (size_t)((td * 4 + s2) * 64 + lane) * 16) = (v4u){pkbf(-acc[0][0], -acc[0][1]), pkbf(-acc[0][2], -acc[0][3]), pkbf(-acc[1][0], -acc[1][1]), pkbf(-acc[1][2], -acc[1][3])}; }
    P2_FRESH();
#pragma unroll
        for (int ti = 0; ti < 4; ++ti) { f32x4 acc = (f32x4){0.f, 0.f, 0.f, 0.f};
#pragma unroll
            for (int s = 0; s < 2; ++s) { const bf16x8 af = *(const LAS bf16x8*)(L + L_KBT + (16 * td + n) * PT + 64 * s + 16 * q); const bf16x8 bfr = *(const LAS bf16x8*)(L + L_QK + (16 * ti + n) * PT + 64 * s + 16 * q); acc = MFMA16(af, bfr, acc); }
            const int i = 16 * ti + n; const float ei = LE[i]; const unsigned long long qv = *(const LAS unsigned long long*)(L + L_QR + i * PK + 2 * (16 * td + 4 * q));
            const unsigned q01 = (unsigned)qv, q23 = (unsigned)(qv >> 32);
            *(unsigned long long*)(rec + CH_QE + (size_t)((ti * 4 + (td >> 1)) * 64 + lane) * 16 + 8 * (td & 1)) =
                (unsigned long long)pkbf(bflo(q01) * ei - acc[0], bfhi(q01) * ei - acc[1]) | ((unsigned long long)pkbf(bflo(q23) * ei - acc[2], bfhi(q23) * ei - acc[3]) << 32); }
    P2_FRESH();
#pragma unroll
        for (int sl = 0; sl < 8; ++sl) { f32x4 acc = (f32x4){0.f, 0.f, 0.f, 0.f};
#pragma unroll
            for (int s = 0; s < 2; ++s) { const bf16x8 af = *(const LAS bf16x8*)(L + L_KTD + (16 * td + n) * PT + 64 * s + 16 * q); const bf16x8 bfr = *(const LAS bf16x8*)(L + L_VBT + (16 * sl + n) * PT + 64 * s + 16 * q); acc = MFMA16(af, bfr, acc); }
            *(unsigned long long*)(rec + CH_N + (size_t)((sl * 8 + td) * 64 + lane) * 8) = (unsigned long long)pkbf(acc[0], acc[1]) | ((unsigned long long)pkbf(acc[2], acc[3]) << 32); }
    P2_FRESH();
#pragma unroll
        for (int ti = 0; ti < 4; ++ti) { f32x4 acc = (f32x4){0.f, 0.f, 0.f, 0.f};
#pragma unroll
            for (int s = 0; s < 2; ++s) { if (32 * s > 16 * ti + 15) continue;
                const bf16x8 af = *(const LAS bf16x8*)(L + L_QK + (16 * ti + n) * PT + 64 * s + 16 * q); const bf16x8 bfr = *(const LAS bf16x8*)(L + L_VBT + (16 * w + n) * PT + 64 * s + 16 * q); acc = MFMA16(af, bfr, acc); }
            if (DBG_P2C == 1) acc = (f32x4){0.125f, 0.25f, 0.5f, 1.0f};
            if (DBG_P2C == 2) { for (int r = 0; r < 4; ++r) acc[r] = bf2f(*(const LAS unsigned short*)(L + L_QK + (16 * ti + 4 * q + r) * PT + 2 * (16 * (w & 3) + n))); }
            if (DBG_P2C == 3) { for (int r = 0; r < 4; ++r) acc[r] = bf2f(*(const LAS unsigned short*)(L + L_VBT + (16 * w + n) * PT + 2 * (16 * ti + 4 * q + r))); }
            if (DBG_P2C == 4) { for (int r = 0; r < 4; ++r) acc[r] = bf2f(*(const LAS unsigned short*)(L + L_TB + (16 * ti + 4 * q + r) * PT + 2 * (16 * (w & 3) + n))); }
            if (DBG_P2C == 6) { for (int r = 0; r < 4; ++r) acc[r] = bf2f(*(const LAS unsigned short*)(L + L_KR + (16 * ti + 4 * q + r) * PK + 2 * (16 * w + n))); }
            if (DBG_P2C == 7) { for (int r = 0; r < 4; ++r) acc[r] = *(const LAS float*)(L + L_AF + (16 * ti + 4 * q + r) * PA + 4 * (16 * (w & 3) + n)); }
            *(unsigned long long*)(rec + CH_OL + (size_t)((w * 4 + ti) * 64 + lane) * 8) = (unsigned long long)pkbf(acc[0], acc[1]) | ((unsigned long long)pkbf(acc[2], acc[3]) << 32); }
    }
    __syncthreads();
#undef P2_FRESH
}
__device__ __forceinline__ void p2_fast(Frame& F, const Args& A) {
    for (int u = blockIdx.x; u < BATCH * NH * 64; u += F.G) p2_unit(F, A, u & 31, u >> 5);
}

constexpr int SC_SLOT = 49152;
__device__ __forceinline__ void p3_fast(Frame& F, const Args& A) {
    LAS unsigned char* L = F.lds; unsigned char* ws = A.ws;
    const int bid = blockIdx.x; if (bid >= 256) return;
    const int xq = bid & 7, yq = bid >> 3; const int bh = 4 * xq + (yq >> 3), sl = yq & 7, b = bh >> 2, h = bh & 3;
    const int w = F.wave, lane = F.lane, q = lane >> 4, n = lane & 15;
    const unsigned char* recs = ws + WS_CH + (size_t)bh * 64 * CH_BYTES;
    bf16* O = (bf16*)(ws + WS_O);
    const float* DEC = (const float*)(ws + WS_DEC) + bh * 64;
#define SC_ISSUE(cc) do { if (w > 0 && (cc) < 64) { const unsigned char* src_ = recs + (size_t)(cc) * CH_BYTES; const int slot_ = ((cc) % 3) * SC_SLOT; \
        _Pragma("unroll") for (int i_ = 0; i_ < 7; ++i_) { const int p_ = (w - 1) + 7 * i_; if (p_ < 48) \
            __builtin_amdgcn_global_load_lds((const unsigned*)(src_ + p_ * 1024 + lane * 16), (LAS unsigned*)(L + slot_ + p_ * 1024), 16, 0, 0); } } } while (0)
    SC_ISSUE(0); SC_ISSUE(1);
    f32x4 S[8];
#pragma unroll
    for (int rb = 0; rb < 8; ++rb) S[rb] = (f32x4){0.f, 0.f, 0.f, 0.f};
    for (int c = 0; c < 64; ++c) {
        if (w > 0) { if (c + 1 < 64) { if (w <= 6) asm volatile("s_waitcnt vmcnt(7)" ::: "memory"); else asm volatile("s_waitcnt vmcnt(6)" ::: "memory"); } else asm volatile("s_waitcnt vmcnt(0)" ::: "memory"); }
        __builtin_amdgcn_s_barrier(); asm volatile("" ::: "memory");
        SC_ISSUE(c + 2);
        if (w == 0) {
            const LAS unsigned char* slot = L + (c % 3) * SC_SLOT; const unsigned char* rec = recs + (size_t)c * CH_BYTES;
            const float dec = DEC[c];
            bf16x8 bS[4];
#pragma unroll
            for (int s = 0; s < 4; ++s) { v4u t = (v4u){pkbf(S[2 * s][0], S[2 * s][1]), pkbf(S[2 * s][2], S[2 * s][3]), pkbf(S[2 * s + 1][0], S[2 * s + 1][1]), pkbf(S[2 * s + 1][2], S[2 * s + 1][3])}; bS[s] = __builtin_bit_cast(bf16x8, t); }
#pragma unroll
            for (int ib = 0; ib < 4; ++ib) { const unsigned long long ov = *(const unsigned long long*)(rec + CH_OL + (size_t)((sl * 4 + ib) * 64 + lane) * 8);
                f32x4 acc = (f32x4){bflo((unsigned)ov), bfhi((unsigned)ov), bflo((unsigned)(ov >> 32)), bfhi((unsigned)(ov >> 32))};
#pragma unroll
                for (int s = 0; s < 4; ++s) { const bf16x8 af = *(const LAS bf16x8*)(slot + CH_QE + ((ib * 4 + s) * 64 + lane) * 16); if (DBG_T2 == 0) acc = MFMA16(af, bS[s], acc); }
#pragma unroll
                for (int r = 0; r < 4; ++r) O[((size_t)b * SEQ + 64 * c + 16 * ib + 4 * q + r) * 512 + h * HD + 16 * sl + n] = (bf16)f2bf(DBG_T1 == 1 ? 0.25f : (DBG_T1 == 2 ? ((fabsf(acc[r]) < 1e30f) ? acc[r] : 0.f) : acc[r])); }
#pragma unroll
            for (int rb = 0; rb < 8; ++rb) { const unsigned long long nv = *(const unsigned long long*)(rec + CH_N + (size_t)((sl * 8 + rb) * 64 + lane) * 8);
                f32x4 acc = S[rb] * dec + (f32x4){bflo((unsigned)nv), bfhi((unsigned)nv), bflo((unsigned)(nv >> 32)), bfhi((unsigned)(nv >> 32))};
#pragma unroll
                for (int s = 0; s < 4; ++s) { const bf16x8 af = *(const LAS bf16x8*)(slot + CH_G + ((rb * 4 + s) * 64 + lane) * 16); acc = MFMA16(af, bS[s], acc); }
                S[rb] = acc; }
        }
    }
    asm volatile("s_waitcnt vmcnt(0)" ::: "memory"); __syncthreads();
#undef SC_ISSUE
}

__device__ __forceinline__ void p4_gate(Frame& F, const Args& A) {
    unsigned char* ws = A.ws; const float* dn_norm_w = A.in[8];
    const bf16* O = (const bf16*)(ws + WS_O); bf16* Y = (bf16*)(ws + WS_Y); const bf16* DZ = (const bf16*)(ws + WS_PROJ + 5 * SEG_BYTES);
    const int gw = F.vcu * NWAVES + F.wave, NGW = F.G * NWAVES;
    const f32x2 nwv = *(const f32x2*)(dn_norm_w + 2 * F.lane);
    for (int m = gw; m < M; m += NGW) {
#pragma unroll
        for (int h = 0; h < NH; ++h) { const size_t off = (size_t)m * 512 + h * HD + 2 * F.lane; const unsigned ov = *(const unsigned*)(O + off); float o0 = bflo(ov), o1 = bfhi(ov); if (!(fabsf(o0) < 1e30f)) o0 = 0.f; if (!(fabsf(o1) < 1e30f)) o1 = 0.f;
            const float ss = wave_sum(o0 * o0 + o1 * o1); const float rstd = 1.0f / sqrtf(ss * (1.f / HD) + EPS); const unsigned z = *(const unsigned*)(DZ + off);
            *(unsigned*)(Y + (size_t)m * DM + DPOOL + h * HD + 2 * F.lane) = pk2(o0 * rstd * nwv.x * bflo(z), o1 * rstd * nwv.y * bfhi(z)); } }
}

__device__ __forceinline__ void p4_naive(Frame& F, const Args& A) {
    unsigned char* ws = A.ws; const float* pool_w = A.in[3]; const float* pool_scale = A.in[4]; const float* dn_norm_w = A.in[8];
    bf16* Y = (bf16*)(ws + WS_Y);
    const bf16* PU = (const bf16*)(ws + WS_PROJ); const bf16* PZ = (const bf16*)(ws + WS_PROJ + SEG_BYTES); const bf16* DZ = (const bf16*)(ws + WS_PROJ + 5 * SEG_BYTES);
    const int g = blockIdx.x & 3; const int win = 2 << g;
    LAS float* lw = (LAS float*)(F.lds); LAS float* mixb = lw + 128 * 128 + F.wave * 128;
    for (int idx = F.tid; idx < 128 * 128; idx += NWAVES * 64) lw[idx] = pool_w[(size_t)g * 128 * 128 + idx];
    __syncthreads();
    const int wg = (blockIdx.x >> 2) * NWAVES + F.wave, NWG = (F.G >> 2) * NWAVES;
    const float sc0 = pool_scale[g * 128 + F.lane], sc1 = pool_scale[g * 128 + F.lane + 64];
    for (int m = wg; m < M; m += NWG) { const int s = m % SEQ; const int cnt = (s + 1) < win ? (s + 1) : win;
        float s0 = 0.f, s1 = 0.f, u0 = 0.f, u1 = 0.f;
        for (int j = 0; j < cnt; ++j) { const unsigned u = *(const unsigned*)(PU + (size_t)(m - j) * 512 + g * 128 + 2 * F.lane); const float f0 = bflo(u), f1 = bfhi(u); s0 += f0; s1 += f1; if (j == 0) { u0 = f0; u1 = f1; } }
        const float inv = 1.0f / (float)cnt;
        mixb[2 * F.lane] = s0 * inv - u0; mixb[2 * F.lane + 1] = s1 * inv - u1;
        asm volatile("s_waitcnt lgkmcnt(0)" ::: "memory");
        float acc0 = 0.f, acc1 = 0.f;
#pragma unroll 8
        for (int c = 0; c < 128; ++c) { const float mv = mixb[c]; acc0 += mv * lw[c * 128 + F.lane]; acc1 += mv * lw[c * 128 + F.lane + 64]; }
        asm volatile("s_waitcnt lgkmcnt(0)" ::: "memory");
        const float z0 = bf2f(PZ[(size_t)m * 512 + g * 128 + F.lane]), z1 = bf2f(PZ[(size_t)m * 512 + g * 128 + F.lane + 64]);
        Y[(size_t)m * DM + g * 128 + F.lane] = (bf16)f2bf(acc0 * sc0 * z0); Y[(size_t)m * DM + g * 128 + F.lane + 64] = (bf16)f2bf(acc1 * sc1 * z1); }
}

__device__ __forceinline__ void p6_final_norm(Frame& F, const Args& A) {
    const float* fw = A.in[10]; float* out = A.out;
    const int gw = F.vcu * NWAVES + F.wave, NGW = F.G * NWAVES;
    f32x4 nw[4];
#pragma unroll
    for (int j = 0; j < 4; ++j) nw[j] = *(const f32x4*)(fw + 4 * F.lane + 256 * j);
    for (int m = gw; m < M; m += NGW) {
        GAS f32x4* xr = (GAS f32x4*)(out + (size_t)m * DM) + F.lane;
        f32x4 v[4]; float s2 = 0.f;
#pragma unroll
        for (int j = 0; j < 4; ++j) { v[j] = xr[64 * j]; s2 += (v[j].x * v[j].x + v[j].y * v[j].y) + (v[j].z * v[j].z + v[j].w * v[j].w); }
        const float rstd = 1.0f / sqrtf(wave_sum(s2) * (1.f / DM) + EPS);
#pragma unroll
        for (int j = 0; j < 4; ++j) xr[64 * j] = v[j] * rstd * nw[j];
    }
}

__global__ void __launch_bounds__(NWAVES * 64, 2) fwd(Args args) {
    extern __shared__ __attribute__((aligned(16))) unsigned char lds[];
    Frame F;
    F.lds = (LAS unsigned char*)lds;
    F.MISC = (volatile LAS unsigned*)(F.lds + MISC_OFF);
    F.tid = threadIdx.x; F.lane = F.tid & 63; F.wave = __builtin_amdgcn_readfirstlane(F.tid >> 6);
    F.G = gridDim.x; { const int bx = blockIdx.x; F.vcu = (F.G % 8 == 0) ? (bx % 8) * (F.G / 8) + bx / 8 : bx; }
    unsigned char* ws = args.ws;
    F.ctl = (gu32*)(ws + WS_CTL);
    for (int u = F.tid; u < (LDS_BYTES - LDSCTL_OFF) / 4; u += NWAVES * 64) ((LAS unsigned*)(F.lds + LDSCTL_OFF))[u] = 0u;
    __syncthreads();
    XcdBarrier bar; bar.bar = (unsigned*)(F.ctl + CW_BAR); bar.x = 0; bar.st = nullptr;
    if (N_LAUNCHES == 1) bar = xcd_barrier_post((unsigned*)(F.ctl + CW_BAR), F.MISC + 8);
    const int lo = args.ph_lo, hi = args.ph_hi;
#define IN(k) (lo <= (k) && (k) < hi)
#define BOTH(k) (IN(k) && IN((k) + 1))
#define GRID_BAR() do { xcd_barrier(bar); } while (0)

    if (IN(0)) { p0_prologue(F, args); if (BOTH(0)) GRID_BAR(); }
    if (IN(1)) {
        pg8::Gemm g{(const pg8::bf16_t*)(ws + WS_XN), (const pg8::bf16_t*)(ws + WS_WIN), M, NPROJ, DM}; pg8::StaticOrder S; S.init(M, NPROJ, F.G, (int)blockIdx.x);
        pg8::EpiProj E{(pg8::bf16_t*)(ws + WS_PROJ), SEG_BYTES / 2};
        pg8::gemm_phase<pg8::EpiProj, pg8::StaticOrder, true, true>(F.lds + RING_OFF, g, S, E);
        if (BOTH(1)) GRID_BAR();
    }
    if (IN(2)) { p2_fast(F, args); if (BOTH(2)) GRID_BAR(); }
    if (IN(3)) { p3_fast(F, args); if (BOTH(3)) GRID_BAR(); }
    if (IN(4)) { p4_gate(F, args); p4_naive(F, args); if (BOTH(4)) GRID_BAR(); }
    if (IN(5)) {
        pg8::Gemm g{(const pg8::bf16_t*)(ws + WS_Y), (const pg8::bf16_t*)(ws + WS_WOUT), M, DM, DM}; pg8::StaticOrder S; S.init(M, DM, F.G, (int)blockIdx.x);
        pg8::EpiResF32 E{args.in[0], args.out, DM};
        pg8::gemm_phase<pg8::EpiResF32, pg8::StaticOrder, true, true>(F.lds + RING_OFF, g, S, E);
        if (BOTH(5)) GRID_BAR();
    }
    if (IN(6)) { p6_final_norm(F, args); }
#undef IN
#undef BOTH
}

extern "C" void kernel_launch(void* const* d_in, const int* in_sizes, int n_in, void* d_out, int out_size, void* d_ws, size_t ws_size, hipStream_t stream) {
    static int grid = 0;
    if (grid == 0) {
        if (n_in != 11 || in_sizes[0] != M * DM || out_size != M * DM || ws_size < WS_END) { fprintf(stderr, "kernel_launch: unexpected shapes: n_in %d in0 %d out %d ws %zu\n", n_in, n_in > 0 ? in_sizes[0] : -1, out_size, ws_size); grid = -1; return; }
        int dev = 0, cus = 0, per_cu = 0;
        if (hipGetDevice(&dev) != hipSuccess || hipDeviceGetAttribute(&cus, hipDeviceAttributeMultiprocessorCount, dev) != hipSuccess) { grid = -1; return; }
        if (hipFuncSetAttribute((const void*)fwd, hipFuncAttributeMaxDynamicSharedMemorySize, LDS_BYTES) != hipSuccess) { fprintf(stderr, "kernel_launch: hipFuncSetAttribute failed\n"); grid = -1; return; }
        if (hipOccupancyMaxActiveBlocksPerMultiprocessor(&per_cu, (const void*)fwd, NWAVES * 64, LDS_BYTES) != hipSuccess || per_cu < 1) fprintf(stderr, "kernel_launch: occupancy query reports %d\n", per_cu);
        (void)hipGetLastError();
        grid = 256; if (cus != 256) fprintf(stderr, "kernel_launch: expected 256 CUs, device reports %d\n", cus);
    }
    if (grid < 0) return;
    if (hipMemsetAsync((char*)d_ws + WS_CTL, 0, CTL_ZERO_BYTES, stream) != hipSuccess) return;
    Args a{};
    for (int i = 0; i < 11; ++i) a.in[i] = (const float*)d_in[i];
    a.out = (float*)d_out; a.ws = (unsigned char*)d_ws;
    for (int li = 0; li < N_LAUNCHES; ++li) {
        a.ph_lo = (N_LAUNCHES == 1) ? 0 : li; a.ph_hi = (N_LAUNCHES == 1) ? N_PHASES : li + 1;
        hipLaunchKernelGGL(fwd, dim3(grid), dim3(NWAVES * 64), LDS_BYTES, stream, a);
        if (hipPeekAtLastError() != hipSuccess) { fprintf(stderr, "kernel_launch: launch %d failed\n", li); break; }
    }
}
```

```cpp
#include <hip/hip_runtime.h>
#include <cstdio>
#include <cstdint>
namespace pg8 {
#define PG8_LAS __attribute__((address_space(3)))
typedef unsigned short bf16_t;
typedef short bf16x8 __attribute__((ext_vector_type(8)));
typedef float f32x4 __attribute__((ext_vector_type(4)));
typedef unsigned u32x4 __attribute__((ext_vector_type(4)));
constexpr int BM = 256, BK = 64, HALF = 128, HTB = HALF * BK * 2  , STAGE_BYTES = 8 * HTB, NXCD = 8, WGM = 8;

__host__ __device__ __forceinline__ int lds_byte(int r, int c) { const int st = (r >> 4) * 2 + (c >> 5), rr = r & 15, cc = c & 31, ob = rr * 64 + cc * 2; return st * 1024 + (ob ^ (((ob >> 9) & 1) << 5)); }
__host__ __device__ __forceinline__ void stage_rc(int b, int& R, int& C) { const int st = b / 1024, sb = b % 1024, swz = sb ^ (((sb >> 9) & 1) << 5); R = (st >> 1) * 16 + swz / 64; C = (st & 1) * 32 + (swz % 64) / 2; }
__host__ __device__ __forceinline__ int perm32(int rho) { const int n = rho >> 4, i = rho & 15; return 8 * (i >> 2) + 4 * n + (i & 3); }

struct Unit { int pm, pn; };
struct Gemm { const bf16_t* A; const bf16_t* Bt; int M, N, K; };

struct StaticOrder {
    int nM, nN, nwg, G, c;
    __host__ __device__ void init(int M, int N, int G_, int c_) { nM = M / BM; nN = N / BM; nwg = nM * nN; G = G_; c = c_; }
    __host__ __device__ bool next(int i, Unit& u) const {
        const long L = (long)i * G + c; if (L >= nwg) return false;
        int wgid = (int)L; { const int q = nwg / NXCD, r = nwg % NXCD, xcd = wgid % NXCD, off = wgid / NXCD; wgid = (xcd < r ? xcd * (q + 1) : r * (q + 1) + (xcd - r) * q) + off; }
        const int nig = WGM * nN, gid = wgid / nig, fm = gid * WGM, gsz = (nM - fm) < WGM ? (nM - fm) : WGM;
        u.pm = fm + ((wgid % nig) % gsz); u.pn = (wgid % nig) / gsz; return true;
    }
    __device__ __forceinline__ void a_ready(const Unit&) const {}
    __device__ __forceinline__ void done(const Unit&) const {}
};

typedef float f32x2 __attribute__((ext_vector_type(2)));
typedef __bf16 bf16x2v __attribute__((ext_vector_type(2)));
__device__ __forceinline__ unsigned cvt_pk_bf16(float lo, float hi) { const bf16x2v v = __builtin_convertvector((f32x2){lo, hi}, bf16x2v); return __builtin_bit_cast(unsigned, v); }
__device__ __forceinline__ float silu_f(float v) { return v * __builtin_amdgcn_rcpf(1.0f + __builtin_amdgcn_exp2f(v * -1.4426950408889634f)); }

struct EpiProj {
    static constexpr bool PERM = true, AFTER_DRAIN = false;
    bf16_t* O; size_t seg_stride;
    __device__ __forceinline__ void operator()(const f32x4 (&acc)[2][2][4][2], const Unit& u, int wr, int wc, int fr, int fq) const {
        const int row0 = u.pm * BM + wr * 64 + fr; const int colt0 = u.pn * BM; const int t = colt0 / 512; const int colt = colt0 - t * 512;
        bf16_t* base = O + (size_t)t * seg_stride; const bool act = (t == 1) || (t == 5);
        const int col0 = colt + wc * 32 + 8 * fq;
#pragma unroll
        for (int ai = 0; ai < 2; ++ai)
#pragma unroll
            for (int m = 0; m < 4; ++m) { bf16_t* rowp = base + (size_t)(row0 + ai * HALF + m * 16) * 512 + col0;
#pragma unroll
                for (int bj = 0; bj < 2; ++bj) { f32x4 v0 = acc[ai][bj][m][0], v1 = acc[ai][bj][m][1];
                    if (act) {
#pragma unroll
                        for (int e = 0; e < 4; ++e) { v0[e] = silu_f(v0[e]); v1[e] = silu_f(v1[e]); } }
                    u32x4 w; w.x = cvt_pk_bf16(v0[0], v0[1]); w.y = cvt_pk_bf16(v0[2], v0[3]); w.z = cvt_pk_bf16(v1[0], v1[1]); w.w = cvt_pk_bf16(v1[2], v1[3]);
                    *(u32x4*)(rowp + bj * HALF) = w; } }
    }
};

struct EpiResF32 {
    static constexpr bool PERM = false, AFTER_DRAIN = false;
    const float* base; float* C; int ldc;
    __device__ __forceinline__ void operator()(const f32x4 (&acc)[2][2][4][2], const Unit& u, int wr, int wc, int fr, int fq) const {
        const int row0 = u.pm * BM + wr * 64 + fr, col0 = u.pn * BM + wc * 32 + 4 * fq;
#pragma unroll
        for (int ai = 0; ai < 2; ++ai)
#pragma unroll
            for (int m = 0; m < 4; ++m) { const size_t off = (size_t)(row0 + ai * HALF + m * 16) * ldc + col0;
#pragma unroll
                for (int bj = 0; bj < 2; ++bj)
#pragma unroll
                    for (int n = 0; n < 2; ++n) *(f32x4*)(C + off + bj * HALF + n * 16) = *(const f32x4*)(base + off + bj * HALF + n * 16) + acc[ai][bj][m][n]; }
    }
};
template <class Epi, class Sched, bool ALIGN_EPI = false, bool SP2 = false>
__device__ __forceinline__ void gemm_phase(PG8_LAS unsigned char* lds, const Gemm g, const Sched& S, const Epi& E) {
    const int tid = threadIdx.x, wid = __builtin_amdgcn_readfirstlane(tid >> 6), lane = tid & 63, wr = wid >> 2, wc = wid & 3, fr = lane & 15, fq = lane >> 4;
    const int K = g.K, nt = K / BK;
    unsigned voffA[2], voffB[2];
#pragma unroll
    for (int i = 0; i < 2; ++i) { int R, C; stage_rc(tid * 16 + i * 8192, R, C); const int Rb = Epi::PERM ? ((R & ~31) + perm32(R & 31)) : R;
        voffA[i] = (unsigned)(R * K + C) * 2u; voffB[i] = (unsigned)(Rb * K + C) * 2u; }
    const size_t kstep = (size_t)(BK * 2);
    const size_t hstep = (size_t)HALF * K * 2;
    const size_t tstep = 2 * hstep;
    const unsigned ldsw = (unsigned)wid * 1024u;
    const int aoff = lds_byte(wr * 64 + fr, fq * 8), boff = lds_byte(wc * 32 + fr, fq * 8);
#define PG8_SA(b, h) (((b) * 2 + (h)) * HTB)
#define PG8_SB(b, h) ((4 + (b) * 2 + (h)) * HTB)
#define PG8_STAGE(bufoff, gbase, voff) do { _Pragma("unroll") for (int _i = 0; _i < 2; ++_i) \
        __builtin_amdgcn_global_load_lds((const unsigned*)((const char*)(gbase) + (voff)[_i]), (PG8_LAS unsigned*)(lds + (bufoff) + ldsw + _i * 8192), 16, 0, 0); } while (0)
#define PG8_LDA(dst, b, h) do { _Pragma("unroll") for (int m = 0; m < 4; ++m) _Pragma("unroll") for (int k = 0; k < 2; ++k) dst[m][k] = *(const PG8_LAS bf16x8*)(lds + PG8_SA(b, h) + aoff + m * 2048 + k * 1024); } while (0)
#define PG8_LDB(dst, b, h) do { _Pragma("unroll") for (int n = 0; n < 2; ++n) _Pragma("unroll") for (int k = 0; k < 2; ++k) dst[n][k] = *(const PG8_LAS bf16x8*)(lds + PG8_SB(b, h) + boff + n * 2048 + k * 1024); } while (0)
#define PG8_MMA(ai, bj, At, Bt) do { __builtin_amdgcn_s_setprio(1); _Pragma("unroll") for (int m = 0; m < 4; ++m) _Pragma("unroll") for (int n = 0; n < 2; ++n) _Pragma("unroll") for (int k = 0; k < 2; ++k) \
        acc[ai][bj][m][n] = __builtin_amdgcn_mfma_f32_16x16x32_bf16(Bt[n][k], At[m][k], acc[ai][bj][m][n], 0, 0, 0); __builtin_amdgcn_s_setprio(0); } while (0)
#define PG8_WAIT_V(n) asm volatile("s_waitcnt vmcnt(" #n ")" ::: "memory")
#define PG8_WAIT_L(n) asm volatile("s_waitcnt lgkmcnt(" #n ")" ::: "memory")
#define PG8_BAR __builtin_amdgcn_s_barrier()
#define PG8_SCHED __builtin_amdgcn_sched_barrier(0)
    Unit cur, nxt; int ui = 0;
    if (!S.next(0, cur)) return;
    f32x4 acc[2][2][4][2];
#pragma unroll
    for (int a = 0; a < 2; ++a)
#pragma unroll
        for (int b = 0; b < 2; ++b)
#pragma unroll
            for (int m = 0; m < 4; ++m)
#pragma unroll
                for (int n = 0; n < 2; ++n) acc[a][b][m][n] = (f32x4){0.f, 0.f, 0.f, 0.f};
    bf16x8 At[4][2], B0[2][2], B1[2][2];
    const char* cA = (const char*)g.A + (size_t)cur.pm * tstep; const char* cB = (const char*)g.Bt + (size_t)cur.pn * tstep;
    S.a_ready(cur);
    if constexpr (SP2) {
        PG8_STAGE(PG8_SB(0, 0), cB, voffB); PG8_STAGE(PG8_SB(0, 1), cB + hstep, voffB); PG8_STAGE(PG8_SA(0, 0), cA, voffA); PG8_STAGE(PG8_SA(0, 1), cA + hstep, voffA);
        if (wr == 1) PG8_BAR;
        PG8_WAIT_V(2); PG8_BAR;
        PG8_STAGE(PG8_SB(1, 0), cB + kstep, voffB); PG8_STAGE(PG8_SA(1, 0), cA + kstep, voffA); PG8_STAGE(PG8_SB(1, 1), cB + hstep + kstep, voffB);
        PG8_WAIT_V(6); PG8_BAR;
    } else {
        PG8_STAGE(PG8_SB(0, 0), cB, voffB); PG8_STAGE(PG8_SA(0, 0), cA, voffA); PG8_STAGE(PG8_SB(0, 1), cB + hstep, voffB); PG8_STAGE(PG8_SA(0, 1), cA + hstep, voffA);
        if (wr == 1) PG8_BAR;
        PG8_WAIT_V(4); PG8_BAR;
        PG8_STAGE(PG8_SB(1, 0), cB + kstep, voffB); PG8_STAGE(PG8_SA(1, 0), cA + kstep, voffA); PG8_STAGE(PG8_SB(1, 1), cB + hstep + kstep, voffB);
        PG8_WAIT_V(6); PG8_BAR;
    }
    for (;;) {
        const bool has_next = S.next(ui + 1, nxt);
        const char* nA = has_next ? (const char*)g.A + (size_t)nxt.pm * tstep : cA; const char* nB = has_next ? (const char*)g.Bt + (size_t)nxt.pn * tstep : cB;
        for (int t = 0; t < nt; t += 2) {
            const bool last = (t == nt - 2);
            const char* a1 = cA + (size_t)(t + 1) * kstep;
            const char* a2 = last ? nA : cA + (size_t)(t + 2) * kstep; const char* b2 = last ? nB : cB + (size_t)(t + 2) * kstep;
            const char* a3 = a2 + kstep; const char* b3 = b2 + kstep;
            if (last && has_next) S.a_ready(nxt);
            if constexpr (SP2) {
            PG8_LDB(B0, 0, 0); PG8_LDB(B1, 0, 1); PG8_SCHED; PG8_LDA(At, 0, 0); PG8_STAGE(PG8_SA(1, 1), a1 + hstep, voffA);
            PG8_WAIT_V(8); PG8_WAIT_L(0); PG8_BAR; PG8_MMA(0, 0, At, B0); PG8_MMA(0, 1, At, B1); PG8_BAR; PG8_SCHED;
            PG8_LDA(At, 0, 1); PG8_STAGE(PG8_SB(0, 0), b2, voffB); PG8_STAGE(PG8_SB(0, 1), b2 + hstep, voffB); PG8_STAGE(PG8_SA(0, 0), a2, voffA);
            PG8_WAIT_V(8); PG8_WAIT_L(0); PG8_BAR; PG8_MMA(1, 0, At, B0); PG8_MMA(1, 1, At, B1); PG8_BAR; PG8_SCHED;
            PG8_LDB(B0, 1, 0); PG8_LDB(B1, 1, 1); PG8_SCHED; PG8_LDA(At, 1, 0); PG8_STAGE(PG8_SA(0, 1), a2 + hstep, voffA);
            PG8_WAIT_V(8); PG8_WAIT_L(0); PG8_BAR; PG8_MMA(0, 0, At, B0); PG8_MMA(0, 1, At, B1); PG8_BAR; PG8_SCHED;
            PG8_LDA(At, 1, 1); PG8_STAGE(PG8_SB(1, 0), b3, voffB); PG8_STAGE(PG8_SB(1, 1), b3 + hstep, voffB); PG8_STAGE(PG8_SA(1, 0), a3, voffA);
            PG8_WAIT_V(8); PG8_WAIT_L(0); PG8_BAR; PG8_MMA(1, 0, At, B0); PG8_MMA(1, 1, At, B1); PG8_BAR; PG8_SCHED;
            } else {
            PG8_LDB(B0, 0, 0); PG8_SCHED; PG8_LDA(At, 0, 0); PG8_STAGE(PG8_SA(1, 1), a1 + hstep, voffA);
            PG8_WAIT_L(8); PG8_BAR; PG8_WAIT_L(0); PG8_MMA(0, 0, At, B0); PG8_BAR; PG8_SCHED;
            PG8_LDB(B1, 0, 1); PG8_STAGE(PG8_SB(0, 0), b2, voffB);
            PG8_BAR; PG8_WAIT_L(0); PG8_MMA(0, 1, At, B1); PG8_BAR;
            PG8_LDA(At, 0, 1); PG8_STAGE(PG8_SA(0, 0), a2, voffA);
            PG8_BAR; PG8_WAIT_L(0); PG8_MMA(1, 0, At, B0); PG8_BAR; PG8_SCHED;
            PG8_STAGE(PG8_SB(0, 1), b2 + hstep, voffB);
            PG8_WAIT_V(6); PG8_BAR; PG8_MMA(1, 1, At, B1); PG8_BAR;
            PG8_LDB(B0, 1, 0); PG8_SCHED; PG8_LDA(At, 1, 0); PG8_STAGE(PG8_SA(0, 1), a2 + hstep, voffA);
            PG8_WAIT_L(8); PG8_BAR; PG8_WAIT_L(0); PG8_MMA(0, 0, At, B0); PG8_BAR; PG8_SCHED;
            PG8_LDB(B1, 1, 1); PG8_STAGE(PG8_SB(1, 0), b3, voffB);
            PG8_BAR; PG8_WAIT_L(0); PG8_MMA(0, 1, At, B1); PG8_BAR;
            PG8_LDA(At, 1, 1); PG8_STAGE(PG8_SA(1, 0), a3, voffA);
            PG8_BAR; PG8_WAIT_L(0); PG8_MMA(1, 0, At, B0); PG8_BAR; PG8_SCHED;
            PG8_STAGE(PG8_SB(1, 1), b3 + hstep, voffB);
            PG8_WAIT_V(6); PG8_BAR; PG8_MMA(1, 1, At, B1); PG8_BAR;
            }
        }
        if constexpr (ALIGN_EPI) { if (wr == 0) PG8_BAR; }
        if constexpr (!Epi::AFTER_DRAIN) { E(acc, cur, wr, wc, fr, fq); S.done(cur); }
        if (!has_next) break;
#pragma unroll
        for (int a = 0; a < 2; ++a)
#pragma unroll
            for (int b = 0; b < 2; ++b)
#pragma unroll
                for (int m = 0; m < 4; ++m)
#pragma unroll
                    for (int n = 0; n < 2; ++n) acc[a][b][m][n] = (f32x4){0.f, 0.f, 0.f, 0.f};
        cur = nxt; cA = nA; cB = nB; ++ui;
        if constexpr (ALIGN_EPI) { if (wr == 1) PG8_BAR; }
    }
    PG8_WAIT_V(0);
    if constexpr (!ALIGN_EPI) { if (wr == 0) PG8_BAR; }
    PG8_BAR;
    if constexpr (Epi::AFTER_DRAIN) { E.fused(acc, cur, wr, wc, fr, fq, lds, wid, lane); S.done(cur); }
#undef PG8_SA
#undef PG8_SB
#undef PG8_STAGE
#undef PG8_LDA
#undef PG8_LDB
#undef PG8_MMA
#undef PG8_WAIT_V
#undef PG8_WAIT_L
#undef PG8_BAR
#undef PG8_SCHED
}
}
#define GAS __attribute__((address_space(1)))
#define LAS __attribute__((address_space(3)))
typedef unsigned short bf16;
typedef unsigned v4u __attribute__((ext_vector_type(4)));
typedef float f32x4 __attribute__((ext_vector_type(4)));
typedef short bf16x8 __attribute__((ext_vector_type(8)));
typedef GAS unsigned gu32;
typedef GAS unsigned long long gu64;
#define RLX_AGENT __ATOMIC_RELAXED, __HIP_MEMORY_SCOPE_AGENT
#define LDS_WAIT() asm volatile("s_waitcnt lgkmcnt(0)" ::: "memory")
#define VM_WAIT() asm volatile("s_waitcnt vmcnt(0)" ::: "memory")
__device__ __forceinline__ unsigned long long rt() { return __builtin_amdgcn_s_memrealtime(); }
__device__ __forceinline__ unsigned f2bf(float f) { unsigned u = __builtin_bit_cast(unsigned, f); return (u + 0x7fffu + ((u >> 16) & 1u)) >> 16; }
__device__ __forceinline__ unsigned pk2(float lo, float hi) { return f2bf(lo) | (f2bf(hi) << 16); }

#define XB_TMO      128
#define XB_XCNT(j)  (256  + 64 * (j))
#define XB_XSUB(j)  (1280 + 64 * (j))
#define XB_XGEN(j)  (2304 + 64 * (j))
#define XB_TOP      3328
#define XB_TOPGEN   3392
#define XCD_BAR_WORDS 3456
#define XB_SPIN_CAP (1u << 18)

__device__ __forceinline__ unsigned xb_ld(unsigned* p)              { return __hip_atomic_load(p, __ATOMIC_RELAXED, __HIP_MEMORY_SCOPE_AGENT); }
__device__ __forceinline__ unsigned xb_add(unsigned* p, unsigned v) { return __hip_atomic_fetch_add(p, v, __ATOMIC_RELAXED, __HIP_MEMORY_SCOPE_AGENT); }
__device__ __forceinline__ unsigned xb_xcc_id() { return (unsigned)__builtin_amdgcn_s_getreg((3 << 11) | 20) & 0xFu; }
#define XB_SPIN(cond, bar) do { unsigned _sp = 0; while (cond) { __builtin_amdgcn_s_sleep(1); \
    if ((++_sp & 255u) == 0u) { if (xb_ld(&(bar)[XB_TMO])) break; if (_sp > XB_SPIN_CAP) { atomicAdd(&(bar)[XB_TMO], 1u); break; } } } } while (0)

struct XcdBarrier {
    unsigned* bar; unsigned x;
    volatile LAS unsigned* st;
};

__device__ __forceinline__ XcdBarrier xcd_barrier_post(unsigned* bar, volatile LAS unsigned* st) {
    XcdBarrier b; b.bar = bar; b.x = xb_xcc_id(); b.st = st;
    if (threadIdx.x == 0) (void)xb_add(&bar[XB_XCNT(b.x)], 1u);
    return b;
}
__device__ __forceinline__ void xcd_barrier_complete(unsigned* bar, unsigned x, unsigned& nloc, unsigned& nx) {
    const unsigned G = gridDim.x * gridDim.y * gridDim.z;
    unsigned sum, cnt, mine, sp = 0u;
    for (;;) {
        sum = 0u; cnt = 0u; mine = 0u;
#pragma unroll
        for (unsigned j = 0; j < 16; ++j) { const unsigned c = xb_ld(&bar[XB_XCNT(j)]); sum += c; cnt += (c > 0u) ? 1u : 0u; mine = (j == x) ? c : mine; }
        if (sum == G) break;
        __builtin_amdgcn_s_sleep(1);
        if ((++sp & 255u) == 0u) { if (xb_ld(&bar[XB_TMO])) break; if (sp > XB_SPIN_CAP) { atomicAdd(&bar[XB_TMO], 1u); break; } }
    }
    nloc = mine > 0u ? mine : 1u; nx = cnt > 0u ? cnt : 1u;
}

__device__ __forceinline__ void xcd_barrier(const XcdBarrier& b) {
    asm volatile("s_waitcnt vmcnt(0)" ::: "memory");
    __syncthreads();
    if (threadIdx.x == 0) {
        unsigned* bar = b.bar;
        __builtin_amdgcn_s_waitcnt(0);
        unsigned nloc = b.st[0], nx = b.st[1];
        if (nloc == 0u) { xcd_barrier_complete(bar, b.x, nloc, nx); b.st[0] = nloc; b.st[1] = nx; }
        const unsigned old = xb_add(&bar[XB_XSUB(b.x)], 1u);
        const unsigned gen = old / nloc;
        if (old + 1u == (gen + 1u) * nloc) {
            __builtin_amdgcn_fence(__ATOMIC_RELEASE, "agent");
            asm volatile("s_waitcnt vmcnt(0)" ::: "memory");
            const unsigned og = xb_add(&bar[XB_TOP], 1u);
            const unsigned tg = og / nx;
            if (og + 1u == (tg + 1u) * nx) xb_add(&bar[XB_TOPGEN], 1u);
            else XB_SPIN(xb_ld(&bar[XB_TOPGEN]) == tg, bar);
            __builtin_amdgcn_fence(__ATOMIC_ACQUIRE, "agent");
            xb_add(&bar[XB_XGEN(b.x)], 1u);
            asm volatile("s_waitcnt vmcnt(0)" ::: "memory");
        } else {
            XB_SPIN(xb_ld(&bar[XB_XGEN(b.x)]) == gen, bar);
            __builtin_amdgcn_fence(__ATOMIC_ACQUIRE, "agent");
            asm volatile("s_waitcnt vmcnt(0)" ::: "memory");
        }
    }
    __syncthreads();
}
typedef float f32x2 __attribute__((ext_vector_type(2)));

constexpr int NWAVES = 8;
#ifndef MK_N_LAUNCHES
#define MK_N_LAUNCHES 1
#endif
constexpr int N_LAUNCHES = MK_N_LAUNCHES;
constexpr int N_PHASES = 7;
constexpr int BATCH = 8, SEQ = 4096, DM = 1024, M = BATCH * SEQ;
constexpr int DIN = 3080, NPROJ = 3072, NH = 4, HD = 128, DDN = 512, DPOOL = 512, NSEG = 6;
constexpr float EPS = 1e-6f;
constexpr size_t MiB = 1u << 20;
constexpr size_t WS_CTL = 0, CTL_ZERO_BYTES = 1 * MiB;
constexpr size_t WS_WIN = 2 * MiB, WS_WOUT = 8 * MiB;
constexpr size_t WS_BETA = 10 * MiB, WS_G = 10 * MiB + 512 * 1024;
constexpr size_t WS_PROJ = 16 * MiB, SEG_BYTES = 32 * MiB;
constexpr size_t WS_XN = 208 * MiB;
constexpr size_t WS_DEC = 11 * MiB;
constexpr size_t WS_CH = 272 * MiB;
constexpr size_t WS_O = 464 * MiB;
constexpr size_t WS_Y = 80 * MiB;
constexpr size_t WS_END = 496 * MiB;
constexpr int CW_BAR = 4096;
constexpr int RING_OFF = 0, RING_BYTES = 131072;
constexpr int LDS_BYTES = 163840;
constexpr int LDSCTL_OFF = LDS_BYTES - 1024, MISC_OFF = LDSCTL_OFF + 320;

struct Frame {
    LAS unsigned char* lds;
    volatile LAS unsigned* MISC;
    gu32* ctl;
    int tid, lane, wave, vcu, G;
};
__device__ __forceinline__ float wave_sum(float v) {
#pragma unroll
    for (int o = 1; o < 64; o <<= 1) v += __shfl_xor(v, o);
    return v;
}
__device__ __forceinline__ float bf2f(unsigned short u) { return __uint_as_float((unsigned)u << 16); }
__device__ __forceinline__ float bflo(unsigned u) { return __uint_as_float(u << 16); }
__device__ __forceinline__ float bfhi(unsigned u) { return __uint_as_float(u & 0xffff0000u); }
__device__ __forceinline__ float silu(float v) { return v / (1.0f + __expf(-v)); }

__device__ __forceinline__ void p0_transpose_item(const float* W, int K, int ldw, int nblk, bf16* WT, LAS float* scr, int item, int lane) {
    const int kb = item / nblk, nb = item % nblk, k0 = 64 * kb, n0 = 32 * nb;
#pragma unroll 8
    for (int i = 0; i < 32; ++i) { const int kk = 2 * i + (lane >> 5); scr[kk * 33 + (lane & 31)] = W[(size_t)(k0 + kk) * ldw + n0 + (lane & 31)]; }
    LDS_WAIT(); asm volatile("" ::: "memory");
    const int c = lane & 7;
#pragma unroll
    for (int j = 0; j < 4; ++j) { const int n = (lane >> 3) + 8 * j; const LAS float* s = scr + (8 * c) * 33 + n;
        v4u o; o.x = pk2(s[0 * 33], s[1 * 33]); o.y = pk2(s[2 * 33], s[3 * 33]); o.z = pk2(s[4 * 33], s[5 * 33]); o.w = pk2(s[6 * 33], s[7 * 33]);
        *(GAS v4u*)(WT + (size_t)(n0 + n) * K + k0 + 8 * c) = o; }
    LDS_WAIT(); asm volatile("" ::: "memory");
}

struct Args { const float* in[11]; float* out; unsigned char* ws; int ph_lo, ph_hi; };

__device__ __forceinline__ void p0_prologue(Frame& F, const Args& A) {
    unsigned char* ws = A.ws;
    const float* x = A.in[0]; const float* norm_w = A.in[1]; const float* w_in = A.in[2]; const float* a_log = A.in[6]; const float* dt_bias = A.in[7]; const float* w_out = A.in[9];
    bf16* win_t = (bf16*)(ws + WS_WIN); bf16* wout_t = (bf16*)(ws + WS_WOUT); bf16* XN = (bf16*)(ws + WS_XN);
    float* beta = (float*)(ws + WS_BETA); float* gg = (float*)(ws + WS_G);
    LAS float* scr = (LAS float*)(F.lds + RING_OFF + F.wave * 16384);
    const int gw = F.vcu * NWAVES + F.wave, NGW = F.G * NWAVES;
    constexpr int I_IN = (DM / 64) * (NPROJ / 32), I_OUT = (DM / 64) * (DM / 32);
    for (int it = gw; it < I_IN + I_OUT; it += NGW) {
        if (it < I_IN) p0_transpose_item(w_in, DM, DIN, NPROJ / 32, win_t, scr, it, F.lane);
        else p0_transpose_item(w_out, DM, DM, DM / 32, wout_t, scr, it - I_IN, F.lane);
    }
    f32x4 nw[4];
#pragma unroll
    for (int j = 0; j < 4; ++j) nw[j] = *(const f32x4*)(norm_w + 4 * F.lane + 256 * j);
    float alog[4], dtb[4];
#pragma unroll
    for (int h = 0; h < 4; ++h) { alog[h] = a_log[h]; dtb[h] = dt_bias[h]; }
    for (int m = gw; m < M; m += NGW) {
        const GAS f32x4* xr = (const GAS f32x4*)(x + (size_t)m * DM) + F.lane;
        f32x4 v[4]; float s2 = 0.f;
#pragma unroll
        for (int j = 0; j < 4; ++j) { v[j] = xr[64 * j]; s2 += (v[j].x * v[j].x + v[j].y * v[j].y) + (v[j].z * v[j].z + v[j].w * v[j].w); }
        const float rstd = 1.0f / sqrtf(wave_sum(s2) * (1.f / DM) + EPS);
#pragma unroll
        for (int j = 0; j < 4; ++j) v[j] = v[j] * rstd * nw[j];
        GAS unsigned long long* o8 = (GAS unsigned long long*)(XN + (size_t)m * DM) + F.lane;
#pragma unroll
        for (int j = 0; j < 4; ++j) o8[64 * j] = (unsigned long long)pk2(v[j].x, v[j].y) | ((unsigned long long)pk2(v[j].z, v[j].w) << 32);
        float ga[8];
#pragma unroll
        for (int c = 0; c < 8; ++c) ga[c] = 0.f;
#pragma unroll
        for (int j = 0; j < 4; ++j)
#pragma unroll
            for (int e = 0; e < 4; ++e) { const int k = 4 * F.lane + 256 * j + e; const f32x4 w0 = *(const f32x4*)(w_in + (size_t)k * DIN + NPROJ), w1 = *(const f32x4*)(w_in + (size_t)k * DIN + NPROJ + 4);
                const float xv = v[j][e];
                ga[0] += xv * w0.x; ga[1] += xv * w0.y; ga[2] += xv * w0.z; ga[3] += xv * w0.w; ga[4] += xv * w1.x; ga[5] += xv * w1.y; ga[6] += xv * w1.z; ga[7] += xv * w1.w; }
#pragma unroll
        for (int c = 0; c < 8; ++c) ga[c] = wave_sum(ga[c]);
        if (F.lane < 4) { const int h = F.lane; const float bl = h == 0 ? ga[0] : h == 1 ? ga[1] : h == 2 ? ga[2] : ga[3]; const float al = h == 0 ? ga[4] : h == 1 ? ga[5] : h == 2 ? ga[6] : ga[7];
            const float al_ = h == 0 ? alog[0] : h == 1 ? alog[1] : h == 2 ? alog[2] : alog[3]; const float db_ = h == 0 ? dtb[0] : h == 1 ? dtb[1] : h == 2 ? dtb[2] : dtb[3];
            const float z = al + db_; const float sp = fmaxf(z, 0.f) + log1pf(__expf(-fabsf(z)));
            beta[(size_t)m * 4 + h] = 1.0f / (1.0f + __expf(-bl)); gg[(size_t)m * 4 + h] = -__expf(al_) * sp; }
    }
}


typedef short bf16x4 __attribute__((ext_vector_type(4)));
#define DBG_T2 0
#define DBG_P2C 0
#define DBG_T1 0
#define MFMA16(a, b, c) __builtin_amdgcn_mfma_f32_16x16x32_bf16((a), (b), (c), 0, 0, 0)
#define MFMAF32(a, b, c) __builtin_amdgcn_mfma_f32_16x16x4f32((a), (b), (c), 0, 0, 0)
constexpr int CH_G = 0, CH_QE = 32768, CH_N = 49152, CH_OL = 81920, CH_BYTES = 98304;
constexpr int L_KR = 0, L_QR = 17408, L_KTD = 34816, L_VBT = 53248, L_KBT = 71680, L_AF = 90112, L_TF = 107520, L_QK = 124928, L_TB = 134144, L_GT = 143360;
constexpr int PK = 272, PT = 144, PA = 272;
__device__ __forceinline__ float rdlane(float v, int l) { return __int_as_float(__builtin_amdgcn_readlane(__float_as_int(v), l)); }
__device__ __forceinline__ unsigned pkbf(float lo, float hi) { return pg8::cvt_pk_bf16(lo, hi); }

__device__ __forceinline__ void p2_unit(Frame& F, const Args& A, const int bh, const int c) {
    LAS unsigned char* L = F.lds; unsigned char* ws = A.ws;
    const int b = bh >> 2, h = bh & 3, w = F.wave; int lane = F.lane; asm volatile("" : "+v"(lane)); int q = lane >> 4, n = lane & 15;
#define P2_FRESH() do { lane = F.lane; asm volatile("" : "+v"(lane)); q = lane >> 4; n = lane & 15; } while (0)
    const size_t m0 = (size_t)b * SEQ + 64 * c;
    const float* conv_w = A.in[5];
    const float* beta = (const float*)(ws + WS_BETA); const float* gg = (const float*)(ws + WS_G);
    unsigned char* rec = ws + WS_CH + (size_t)(bh * 64 + c) * CH_BYTES;
    LAS float* LG = (LAS float*)(L + L_GT); LAS float* LB = LG + 64; LAS float* LE = LG + 128;
    float gc = gg[(m0 + lane) * 4 + h]; const float be_t = beta[(m0 + lane) * 4 + h];
#pragma unroll
    for (int o = 1; o < 64; o <<= 1) { const float t = __shfl_up(gc, o); if (lane >= o) gc += t; }
    const float gl = rdlane(gc, 63);
    const float E_t = __expf(gc), F_t = __expf(gl - gc);
    if (w == 0) { LG[lane] = gc; LB[lane] = be_t; LE[lane] = E_t; if (lane == 0) ((float*)(ws + WS_DEC))[bh * 64 + c] = __expf(gl); }
#pragma unroll 1
    for (int seg = 0; seg < 3; ++seg) {
        const bf16* src = (const bf16*)(ws + WS_PROJ + (size_t)(2 + seg) * SEG_BYTES) + h * HD + 2 * lane;
        unsigned raw[11];
#pragma unroll
        for (int r = 0; r < 11; ++r) { const int tok = 64 * c + 8 * w + r - 3; raw[r] = (tok >= 0) ? *(const unsigned*)(src + (m0 + 8 * w + r - 3) * 512) : 0u; }
        f32x2 cw[4];
#pragma unroll
        for (int j = 0; j < 4; ++j) cw[j] = *(const f32x2*)(conv_w + (size_t)j * 1536 + seg * 512 + h * HD + 2 * lane);
        float a0[8], a1[8];
#pragma unroll
        for (int i = 0; i < 8; ++i) { float x0 = 0.f, x1 = 0.f;
#pragma unroll
            for (int j = 0; j < 4; ++j) { x0 += cw[j].x * bflo(raw[i + j]); x1 += cw[j].y * bfhi(raw[i + j]); }
            a0[i] = silu(x0); a1[i] = silu(x1); }
        if (seg < 2) {
#pragma unroll
            for (int i = 0; i < 8; ++i) { const float ss = wave_sum(a0[i] * a0[i] + a1[i] * a1[i]); float sc = 1.0f / sqrtf(ss + EPS); if (seg == 0) sc *= 0.08838834764831845f; a0[i] *= sc; a1[i] *= sc; } }
        if (seg == 0) {
#pragma unroll
            for (int i = 0; i < 8; ++i) *(LAS unsigned*)(L + L_QR + (8 * w + i) * PK + 4 * lane) = pkbf(a0[i], a1[i]);
        } else if (seg == 1) {
            float kd0[8], kd1[8], kb0[8], kb1[8];
#pragma unroll
            for (int i = 0; i < 8; ++i) { *(LAS unsigned*)(L + L_KR + (8 * w + i) * PK + 4 * lane) = pkbf(a0[i], a1[i]);
                const float fi = __shfl(F_t, 8 * w + i), bi = __shfl(be_t, 8 * w + i) * __shfl(E_t, 8 * w + i);
                kd0[i] = a0[i] * fi; kd1[i] = a1[i] * fi; kb0[i] = a0[i] * bi; kb1[i] = a1[i] * bi; }
            *(LAS v4u*)(L + L_KTD + (2 * lane) * PT + 16 * w) = (v4u){pkbf(kd0[0], kd0[1]), pkbf(kd0[2], kd0[3]), pkbf(kd0[4], kd0[5]), pkbf(kd0[6], kd0[7])};
            *(LAS v4u*)(L + L_KTD + (2 * lane + 1) * PT + 16 * w) = (v4u){pkbf(kd1[0], kd1[1]), pkbf(kd1[2], kd1[3]), pkbf(kd1[4], kd1[5]), pkbf(kd1[6], kd1[7])};
            *(LAS v4u*)(L + L_KBT + (2 * lane) * PT + 16 * w) = (v4u){pkbf(kb0[0], kb0[1]), pkbf(kb0[2], kb0[3]), pkbf(kb0[4], kb0[5]), pkbf(kb0[6], kb0[7])};
            *(LAS v4u*)(L + L_KBT + (2 * lane + 1) * PT + 16 * w) = (v4u){pkbf(kb1[0], kb1[1]), pkbf(kb1[2], kb1[3]), pkbf(kb1[4], kb1[5]), pkbf(kb1[6], kb1[7])};
        } else {
#pragma unroll
            for (int i = 0; i < 8; ++i) { const float bi = __shfl(be_t, 8 * w + i); a0[i] *= bi; a1[i] *= bi; }
            *(LAS v4u*)(L + L_VBT + (2 * lane) * PT + 16 * w) = (v4u){pkbf(a0[0], a0[1]), pkbf(a0[2], a0[3]), pkbf(a0[4], a0[5]), pkbf(a0[6], a0[7])};
            *(LAS v4u*)(L + L_VBT + (2 * lane + 1) * PT + 16 * w) = (v4u){pkbf(a1[0], a1[1]), pkbf(a1[2], a1[3]), pkbf(a1[4], a1[5]), pkbf(a1[6], a1[7])};
        }
    }
    __syncthreads();
    P2_FRESH();
    {
        const int tp = w >> 1, t2 = 2 * (w & 1);
#pragma unroll
        for (int mat = 0; mat < 2; ++mat)
#pragma unroll
            for (int u2 = 0; u2 < 2; ++u2) {
                const int tr = tp, tc = t2 + u2; f32x4 acc = (f32x4){0.f, 0.f, 0.f, 0.f};
#pragma unroll
                for (int s = 0; s < 4; ++s) { const bf16x8 af = *(const LAS bf16x8*)(L + L_KR + (16 * tr + n) * PK + 64 * s + 16 * q);
                    const bf16x8 bfr = *(const LAS bf16x8*)(L + (mat == 0 ? L_KR : L_QR) + (16 * tc + n) * PK + 64 * s + 16 * q); acc = MFMA16(af, bfr, acc); }
                if (mat == 0) { const int j = 16 * tc + n; const float gj = LG[j];
#pragma unroll
                    for (int r = 0; r < 4; ++r) { const int i = 16 * tr + 4 * q + r; const float v = (i > j) ? LB[i] * acc[r] * __expf(LG[i] - gj) : 0.f; *(LAS float*)(L + L_AF + i * PA + 4 * j) = v; }
                } else { const int i = 16 * tc + n; const float gi = LG[i]; float v[4];
#pragma unroll
                    for (int r = 0; r < 4; ++r) { const int j = 16 * tr + 4 * q + r; v[r] = (i >= j) ? acc[r] * __expf(gi - LG[j]) : 0.f; }
                    *(LAS unsigned long long*)(L + L_QK + i * PT + 2 * (16 * tr + 4 * q)) = (unsigned long long)pkbf(v[0], v[1]) | ((unsigned long long)pkbf(v[2], v[3]) << 32); }
            }
    }
    __syncthreads();
    P2_FRESH();
    if (w == 0) { const int bb = q; float t[16];
#pragma unroll
        for (int i = 0; i < 16; ++i) { float v = (i == n) ? 1.f : 0.f; const LAS unsigned char* ar = L + L_AF + (16 * bb + i) * PA + 4 * 16 * bb;
#pragma unroll
            for (int m4 = 0; m4 < (i + 3) / 4; ++m4) { const f32x4 av = *(const LAS f32x4*)(ar + 16 * m4);
#pragma unroll
                for (int e = 0; e < 4; ++e) if (4 * m4 + e < i) v -= av[e] * t[4 * m4 + e]; }
            t[i] = v; __builtin_amdgcn_sched_barrier(0); }
#pragma unroll
        for (int i = 0; i < 16; ++i) { *(LAS float*)(L + L_TF + (16 * bb + i) * PA + 4 * (16 * bb + n)) = t[i];
#pragma unroll
            for (int b2 = 1; b2 < 4; ++b2) if (b2 > bb) *(LAS float*)(L + L_TF + (16 * bb + i) * PA + 4 * (16 * b2 + n)) = 0.f; }
    }
    __syncthreads();
    P2_FRESH();
    if (w < 2) { const int lo = 2 * w, hi = 2 * w + 1; f32x4 y = (f32x4){0.f, 0.f, 0.f, 0.f};
#pragma unroll
        for (int s = 0; s < 4; ++s) { const float a = *(const LAS float*)(L + L_AF + (16 * hi + n) * PA + 4 * (16 * lo + 4 * s + q)); const float bv = *(const LAS float*)(L + L_TF + (16 * lo + 4 * s + q) * PA + 4 * (16 * lo + n)); y = MFMAF32(a, bv, y); }
        f32x4 x = (f32x4){0.f, 0.f, 0.f, 0.f};
#pragma unroll
        for (int s = 0; s < 4; ++s) { const float a = *(const LAS float*)(L + L_TF + (16 * hi + n) * PA + 4 * (16 * hi + 4 * q + s)); x = MFMAF32(a, y[s], x); }
#pragma unroll
        for (int r = 0; r < 4; ++r) *(LAS float*)(L + L_TF + (16 * hi + 4 * q + r) * PA + 4 * (16 * lo + n)) = -x[r];
    }
    __syncthreads();
    P2_FRESH();
    if (w < 2) { const int ct = w; f32x4 y[2];
#pragma unroll
        for (int kb = 0; kb < 2; ++kb) { y[kb] = (f32x4){0.f, 0.f, 0.f, 0.f};
#pragma unroll
            for (int jb = 0; jb < 2; ++jb)
#pragma unroll
                for (int s = 0; s < 4; ++s) { const float a = *(const LAS float*)(L + L_AF + (32 + 16 * kb + n) * PA + 4 * (16 * jb + 4 * s + q)); const float bv = *(const LAS float*)(L + L_TF + (16 * jb + 4 * s + q) * PA + 4 * (16 * ct + n)); y[kb] = MFMAF32(a, bv, y[kb]); } }
#pragma unroll
        for (int rt = 0; rt < 2; ++rt) { f32x4 x = (f32x4){0.f, 0.f, 0.f, 0.f};
#pragma unroll
            for (int kb = 0; kb < 2; ++kb)
#pragma unroll
                for (int s = 0; s < 4; ++s) { const float a = *(const LAS float*)(L + L_TF + (32 + 16 * rt + n) * PA + 4 * (32 + 16 * kb + 4 * q + s)); x = MFMAF32(a, y[kb][s], x); }
#pragma unroll
            for (int r = 0; r < 4; ++r) *(LAS float*)(L + L_TF + (32 + 16 * rt + 4 * q + r) * PA + 4 * (16 * ct + n)) = -x[r]; }
    }
    __syncthreads();
    P2_FRESH();
    { const int i = F.tid >> 3, j0 = 8 * (F.tid & 7); const f32x4 t0 = *(const LAS f32x4*)(L + L_TF + i * PA + 4 * j0), t1 = *(const LAS f32x4*)(L + L_TF + i * PA + 4 * j0 + 16);
        float v[8] = {t0[0], t0[1], t0[2], t0[3], t1[0], t1[1], t1[2], t1[3]};
#pragma unroll
        for (int e = 0; e < 8; ++e) if (j0 + e > i) v[e] = 0.f;
        *(LAS v4u*)(L + L_TB + i * PT + 2 * j0) = (v4u){pkbf(v[0], v[1]), pkbf(v[2], v[3]), pkbf(v[4], v[5]), pkbf(v[6], v[7])}; }
    __syncthreads();
    P2_FRESH();
    f32x4 uacc[4], wacc[4];
    { const int td = w;
#pragma unroll
        for (int ti = 0; ti < 4; ++ti) { uacc[ti] = (f32x4){0.f, 0.f, 0.f, 0.f}; wacc[ti] = (f32x4){0.f, 0.f, 0.f, 0.f};
#pragma unroll
            for (int s = 0; s < 2; ++s) { if (32 * s > 16 * ti + 15) continue;
                const bf16x8 af = *(const LAS bf16x8*)(L + L_TB + (16 * ti + n) * PT + 64 * s + 16 * q);
                const bf16x8 bu = *(const LAS bf16x8*)(L + L_VBT + (16 * td + n) * PT + 64 * s + 16 * q), bw = *(const LAS bf16x8*)(L + L_KBT + (16 * td + n) * PT + 64 * s + 16 * q);
                uacc[ti] = MFMA16(af, bu, uacc[ti]); wacc[ti] = MFMA16(af, bw, wacc[ti]); } } }
    __syncthreads();
    P2_FRESH();
    { const int td = w;
#pragma unroll
        for (int ti = 0; ti < 4; ++ti) {
            *(LAS unsigned long long*)(L + L_VBT + (16 * td + n) * PT + 2 * (16 * ti + 4 * q)) = (unsigned long long)pkbf(uacc[ti][0], uacc[ti][1]) | ((unsigned long long)pkbf(uacc[ti][2], uacc[ti][3]) << 32);
            *(LAS unsigned long long*)(L + L_KBT + (16 * td + n) * PT + 2 * (16 * ti + 4 * q)) = (unsigned long long)pkbf(wacc[ti][0], wacc[ti][1]) | ((unsigned long long)pkbf(wacc[ti][2], wacc[ti][3]) << 32); } }
    __syncthreads();
    P2_FRESH();
    {
        const int td = w;
#pragma unroll
        for (int s2 = 0; s2 < 4; ++s2) { f32x4 acc[2];
#pragma unroll
            for (int hf = 0; hf < 2; ++hf) { const int tdp = 2 * s2 + hf; acc[hf] = (f32x4){0.f, 0.f, 0.f, 0.f};
#pragma unroll
                for (int s = 0; s < 2; ++s) { const bf16x8 af = *(const LAS bf16x8*)(L + L_KBT + (16 * tdp + n) * PT + 64 * s + 16 * q); const bf16x8 bfr = *(const LAS bf16x8*)(L + L_KTD + (16 * td + n) * PT + 64 * s + 16 * q); acc[hf] = MFMA16(af, bfr, acc[hf]); } }
            *(v4u*)(rec + CH_G + (size_t)((td * 4 + s2) * 64 + lane) * 16) = (v4u){pkbf(-acc[0][0], -acc[0][1]), pkbf(-acc[0][2], -acc[0][3]), pkbf(-acc[1][0], -acc[1][1]), pkbf(-acc[1][2], -acc[1][3])}; }
    P2_FRESH();
#pragma unroll
        for (int ti = 0; ti < 4; ++ti) { f32x4 acc = (f32x4){0.f, 0.f, 0.f, 0.f};
#pragma unroll
            for (int s = 0; s < 2; ++s) { const bf16x8 af = *(const LAS bf16x8*)(L + L_KBT + (16 * td + n) * PT + 64 * s + 16 * q); const bf16x8 bfr = *(const LAS bf16x8*)(L + L_QK + (16 * ti + n) * PT + 64 * s + 16 * q); acc = MFMA16(af, bfr, acc); }
            const int i = 16 * ti + n; const float ei = LE[i]; const unsigned long long qv = *(const LAS unsigned long long*)(L + L_QR + i * PK + 2 * (16 * td + 4 * q));
            const unsigned q01 = (unsigned)qv, q23 = (unsigned)(qv >> 32);
            *(unsigned long long*)(rec + CH_QE + (size_t)((ti * 4 + (td >> 1)) * 64 + lane) * 16 + 8 * (td & 1)) =
                (unsigned long long)pkbf(bflo(q01) * ei - acc[0], bfhi(q01) * ei - acc[1]) | ((unsigned long long)pkbf(bflo(q23) * ei - acc[2], bfhi(q23) * ei - acc[3]) << 32); }
    P2_FRESH();
#pragma unroll
        for (int sl = 0; sl < 8; ++sl) { f32x4 acc = (f32x4){0.f, 0.f, 0.f, 0.f};
#pragma unroll
            for (int s = 0; s < 2; ++s) { const bf16x8 af = *(const LAS bf16x8*)(L + L_KTD + (16 * td + n) * PT + 64 * s + 16 * q); const bf16x8 bfr = *(const LAS bf16x8*)(L + L_VBT + (16 * sl + n) * PT + 64 * s + 16 * q); acc = MFMA16(af, bfr, acc); }
            *(unsigned long long*)(rec + CH_N + (size_t)((sl * 8 + td) * 64 + lane) * 8) = (unsigned long long)pkbf(acc[0], acc[1]) | ((unsigned long long)pkbf(acc[2], acc[3]) << 32); }
    P2_FRESH();
#pragma unroll
        for (int ti = 0; ti < 4; ++ti) { f32x4 acc = (f32x4){0.f, 0.f, 0.f, 0.f};
#pragma unroll
            for (int s = 0; s < 2; ++s) { if (32 * s > 16 * ti + 15) continue;
                const bf16x8 af = *(const LAS bf16x8*)(L + L_QK + (16 * ti + n) * PT + 64 * s + 16 * q); const bf16x8 bfr = *(const LAS bf16x8*)(L + L_VBT + (16 * w + n) * PT + 64 * s + 16 * q); acc = MFMA16(af, bfr, acc); }
            if (DBG_P2C == 1) acc = (f32x4){0.125f, 0.25f, 0.5f, 1.0f};
            if (DBG_P2C == 2) { for (int r = 0; r < 4; ++r) acc[r] = bf2f(*(const LAS unsigned short*)(L + L_QK + (16 * ti + 4 * q + r) * PT + 2 * (16 * (w & 3) + n))); }
            if (DBG_P2C == 3) { for (int r = 0; r < 4; ++r) acc[r] = bf2f(*(const LAS unsigned short*)(L + L_VBT + (16 * w + n) * PT + 2 * (16 * ti + 4 * q + r))); }
            if (DBG_P2C == 4) { for (int r = 0; r < 4; ++r) acc[r] = bf2f(*(const LAS unsigned short*)(L + L_TB + (16 * ti + 4 * q + r) * PT + 2 * (16 * (w & 3) + n))); }
            if (DBG_P2C == 6) { for (int r = 0; r < 4; ++r) acc[r] = bf2f(*(const LAS unsigned short*)(L + L_KR + (16 * ti + 4 * q + r) * PK + 2 * (16 * w + n))); }
            if (DBG_P2C == 7) { for (int r = 0; r < 4; ++r) acc[r] = *(const LAS float*)(L + L_AF + (16 * ti + 4 * q + r) * PA + 4 * (16 * (w & 3) + n)); }
            *(unsigned long long*)(rec + CH_OL + (size_t)((w * 4 + ti) * 64 + lane) * 8) = (unsigned long long)pkbf(acc[0], acc[1]) | ((unsigned long long)pkbf(acc[2], acc[3]) << 32); }
    }
    __syncthreads();
#undef P2_FRESH
}
__device__ __forceinline__ void p2_fast(Frame& F, const Args& A) {
    for (int u = blockIdx.x; u < BATCH * NH * 64; u += F.G) p2_unit(F, A, u & 31, u >> 5);
}

constexpr int SC_SLOT = 49152;
__device__ __forceinline__ void p3_fast(Frame& F, const Args& A) {
    LAS unsigned char* L = F.lds; unsigned char* ws = A.ws;
    const int bid = blockIdx.x; if (bid >= 256) return;
    const int xq = bid & 7, yq = bid >> 3; const int bh = 4 * xq + (yq >> 3), sl = yq & 7, b = bh >> 2, h = bh & 3;
    const int w = F.wave, lane = F.lane, q = lane >> 4, n = lane & 15;
    const unsigned char* recs = ws + WS_CH + (size_t)bh * 64 * CH_BYTES;
    bf16* O = (bf16*)(ws + WS_O);
    const float* DEC = (const float*)(ws + WS_DEC) + bh * 64;
#define SC_ISSUE(cc) do { if (w > 0 && (cc) < 64) { const unsigned char* src_ = recs + (size_t)(cc) * CH_BYTES; const int slot_ = ((cc) % 3) * SC_SLOT; \
        _Pragma("unroll") for (int i_ = 0; i_ < 7; ++i_) { const int p_ = (w - 1) + 7 * i_; if (p_ < 48) \
            __builtin_amdgcn_global_load_lds((const unsigned*)(src_ + p_ * 1024 + lane * 16), (LAS unsigned*)(L + slot_ + p_ * 1024), 16, 0, 0); } } } while (0)
    SC_ISSUE(0); SC_ISSUE(1);
    f32x4 S[8];
#pragma unroll
    for (int rb = 0; rb < 8; ++rb) S[rb] = (f32x4){0.f, 0.f, 0.f, 0.f};
    for (int c = 0; c < 64; ++c) {
        if (w > 0) { if (c + 1 < 64) { if (w <= 6) asm volatile("s_waitcnt vmcnt(7)" ::: "memory"); else asm volatile("s_waitcnt vmcnt(6)" ::: "memory"); } else asm volatile("s_waitcnt vmcnt(0)" ::: "memory"); }
        __builtin_amdgcn_s_barrier(); asm volatile("" ::: "memory");
        SC_ISSUE(c + 2);
        if (w == 0) {
            const LAS unsigned char* slot = L + (c % 3) * SC_SLOT; const unsigned char* rec = recs + (size_t)c * CH_BYTES;
            const float dec = DEC[c];
            bf16x8 bS[4];
#pragma unroll
            for (int s = 0; s < 4; ++s) { v4u t = (v4u){pkbf(S[2 * s][0], S[2 * s][1]), pkbf(S[2 * s][2], S[2 * s][3]), pkbf(S[2 * s + 1][0], S[2 * s + 1][1]), pkbf(S[2 * s + 1][2], S[2 * s + 1][3])}; bS[s] = __builtin_bit_cast(bf16x8, t); }
#pragma unroll
            for (int ib = 0; ib < 4; ++ib) { const unsigned long long ov = *(const unsigned long long*)(rec + CH_OL + (size_t)((sl * 4 + ib) * 64 + lane) * 8);
                f32x4 acc = (f32x4){bflo((unsigned)ov), bfhi((unsigned)ov), bflo((unsigned)(ov >> 32)), bfhi((unsigned)(ov >> 32))};
#pragma unroll
                for (int s = 0; s < 4; ++s) { const bf16x8 af = *(const LAS bf16x8*)(slot + CH_QE + ((ib * 4 + s) * 64 + lane) * 16); if (DBG_T2 == 0) acc = MFMA16(af, bS[s], acc); }
#pragma unroll
                for (int r = 0; r < 4; ++r) O[((size_t)b * SEQ + 64 * c + 16 * ib + 4 * q + r) * 512 + h * HD + 16 * sl + n] = (bf16)f2bf(DBG_T1 == 1 ? 0.25f : (DBG_T1 == 2 ? ((fabsf(acc[r]) < 1e30f) ? acc[r] : 0.f) : acc[r])); }
#pragma unroll
            for (int rb = 0; rb < 8; ++rb) { const unsigned long long nv = *(const unsigned long long*)(rec + CH_N + (size_t)((sl * 8 + rb) * 64 + lane) * 8);
                f32x4 acc = S[rb] * dec + (f32x4){bflo((unsigned)nv), bfhi((unsigned)nv), bflo((unsigned)(nv >> 32)), bfhi((unsigned)(nv >> 32))};
#pragma unroll
                for (int s = 0; s < 4; ++s) { const bf16x8 af = *(const LAS bf16x8*)(slot + CH_G + ((rb * 4 + s) * 64 + lane) * 16); acc = MFMA16(af, bS[s], acc); }
                S[rb] = acc; }
        }
    }
    asm volatile("s_waitcnt vmcnt(0)" ::: "memory"); __syncthreads();
#undef SC_ISSUE
}

__device__ __forceinline__ void p4_gate(Frame& F, const Args& A) {
    unsigned char* ws = A.ws; const float* dn_norm_w = A.in[8];
    const bf16* O = (const bf16*)(ws + WS_O); bf16* Y = (bf16*)(ws + WS_Y); const bf16* DZ = (const bf16*)(ws + WS_PROJ + 5 * SEG_BYTES);
    const int gw = F.vcu * NWAVES + F.wave, NGW = F.G * NWAVES;
    const f32x2 nwv = *(const f32x2*)(dn_norm_w + 2 * F.lane);
    for (int m = gw; m < M; m += NGW) {
#pragma unroll
        for (int h = 0; h < NH; ++h) { const size_t off = (size_t)m * 512 + h * HD + 2 * F.lane; const unsigned ov = *(const unsigned*)(O + off); float o0 = bflo(ov), o1 = bfhi(ov);
            const float ss = wave_sum(o0 * o0 + o1 * o1); const float rstd = 1.0f / sqrtf(ss * (1.f / HD) + EPS); const unsigned z = *(const unsigned*)(DZ + off);
            *(unsigned*)(Y + (size_t)m * DM + DPOOL + h * HD + 2 * F.lane) = pk2(o0 * rstd * nwv.x * bflo(z), o1 * rstd * nwv.y * bfhi(z)); } }
}

constexpr int PL_W = 0, PL_MIX = 34816, PL_PITCH = 272;
template <int WIN>
__device__ __forceinline__ void pool_tiles(Frame& F, const Args& A, const int g) {
    LAS unsigned char* L = F.lds; unsigned char* ws = A.ws; const float* pool_scale = A.in[4];
    const bf16* PU = (const bf16*)(ws + WS_PROJ); const bf16* PZ = (const bf16*)(ws + WS_PROJ + SEG_BYTES); bf16* Y = (bf16*)(ws + WS_Y);
    const int w = F.wave; int lane = F.lane; asm volatile("" : "+v"(lane)); const int q = lane >> 4, n = lane & 15;
    f32x4 sc[8];
#pragma unroll
    for (int td = 0; td < 8; ++td) sc[td] = *(const f32x4*)(pool_scale + g * 128 + 16 * td + 4 * q);
#pragma unroll 1
    for (int it = 0; it < 4; ++it) {
        const int t0 = ((blockIdx.x >> 2) + 64 * it) * 128 + 16 * w;
        const int s0 = t0 % SEQ;
        const bf16* src = PU + (size_t)t0 * 512 + g * 128 + 2 * lane;
        float r0 = 0.f, r1 = 0.f; unsigned hist[WIN];
#pragma unroll
        for (int j = 0; j < WIN; ++j) { hist[j] = (s0 - WIN + j >= 0) ? *(const unsigned*)(src + (ptrdiff_t)(j - WIN) * 512) : 0u; r0 += bflo(hist[j]); r1 += bfhi(hist[j]); }
        unsigned cur[16];
#pragma unroll
        for (int i = 0; i < 16; ++i) cur[i] = *(const unsigned*)(src + (size_t)i * 512);
#pragma unroll
        for (int i = 0; i < 16; ++i) { const unsigned old = (i < WIN) ? hist[i] : cur[i - WIN];
            const float u0 = bflo(cur[i]), u1 = bfhi(cur[i]); r0 += u0 - bflo(old); r1 += u1 - bfhi(old);
            const int cnt = (s0 + i + 1 < WIN) ? (s0 + i + 1) : WIN; const float inv = 1.0f / (float)cnt;
            *(LAS unsigned*)(L + PL_MIX + (16 * w + i) * PL_PITCH + 4 * lane) = pkbf(r0 * inv - u0, r1 * inv - u1); }
        asm volatile("s_waitcnt lgkmcnt(0)" ::: "memory");
        bf16x8 bm[4];
#pragma unroll
        for (int s = 0; s < 4; ++s) bm[s] = *(const LAS bf16x8*)(L + PL_MIX + (16 * w + n) * PL_PITCH + 64 * s + 16 * q);
        const size_t tok = (size_t)t0 + n;
#pragma unroll
        for (int td = 0; td < 8; ++td) { f32x4 acc = (f32x4){0.f, 0.f, 0.f, 0.f};
#pragma unroll
            for (int s = 0; s < 4; ++s) { const bf16x8 af = *(const LAS bf16x8*)(L + PL_W + (16 * td + n) * PL_PITCH + 64 * s + 16 * q); acc = MFMA16(af, bm[s], acc); }
            const unsigned long long zv = *(const unsigned long long*)(PZ + tok * 512 + g * 128 + 16 * td + 4 * q); const unsigned z01 = (unsigned)zv, z23 = (unsigned)(zv >> 32);
            acc = acc * sc[td];
            *(unsigned long long*)(Y + tok * DM + g * 128 + 16 * td + 4 * q) = (unsigned long long)pkbf(acc[0] * bflo(z01), acc[1] * bfhi(z01)) | ((unsigned long long)pkbf(acc[2] * bflo(z23), acc[3] * bfhi(z23)) << 32); }
        asm volatile("s_waitcnt lgkmcnt(0)" ::: "memory");
    }
}
__device__ __forceinline__ void p4_pool(Frame& F, const Args& A) {
    LAS unsigned char* L = F.lds; const float* pool_w = A.in[3];
    const int g = blockIdx.x & 3;
    for (int idx = F.tid; idx < 128 * 32; idx += NWAVES * 64) { const int c = idx >> 5, d0 = 4 * (idx & 31); const f32x4 wv = *(const f32x4*)(pool_w + (size_t)g * 16384 + c * 128 + d0);
#pragma unroll
        for (int e = 0; e < 4; ++e) *(LAS unsigned short*)(L + PL_W + (d0 + e) * PL_PITCH + 2 * c) = (unsigned short)f2bf(wv[e]); }
    __syncthreads();
    if (g == 0) pool_tiles<2>(F, A, 0); else if (g == 1) pool_tiles<4>(F, A, 1); else if (g == 2) pool_tiles<8>(F, A, 2); else pool_tiles<16>(F, A, 3);
    __syncthreads();
}

__device__ __forceinline__ void p6_final_norm(Frame& F, const Args& A) {
    const float* fw = A.in[10]; float* out = A.out;
    const int gw = F.vcu * NWAVES + F.wave, NGW = F.G * NWAVES;
    f32x4 nw[4];
#pragma unroll
    for (int j = 0; j < 4; ++j) nw[j] = *(const f32x4*)(fw + 4 * F.lane + 256 * j);
    for (int m = gw; m < M; m += NGW) {
        GAS f32x4* xr = (GAS f32x4*)(out + (size_t)m * DM) + F.lane;
        f32x4 v[4]; float s2 = 0.f;
#pragma unroll
        for (int j = 0; j < 4; ++j) { v[j] = xr[64 * j]; s2 += (v[j].x * v[j].x + v[j].y * v[j].y) + (v[j].z * v[j].z + v[j].w * v[j].w); }
        const float rstd = 1.0f / sqrtf(wave_sum(s2) * (1.f / DM) + EPS);
#pragma unroll
        for (int j = 0; j < 4; ++j) xr[64 * j] = v[j] * rstd * nw[j];
    }
}

__global__ void __launch_bounds__(NWAVES * 64, 2) fwd(Args args) {
    extern __shared__ __attribute__((aligned(16))) unsigned char lds[];
    Frame F;
    F.lds = (LAS unsigned char*)lds;
    F.MISC = (volatile LAS unsigned*)(F.lds + MISC_OFF);
    F.tid = threadIdx.x; F.lane = F.tid & 63; F.wave = __builtin_amdgcn_readfirstlane(F.tid >> 6);
    F.G = gridDim.x; { const int bx = blockIdx.x; F.vcu = (F.G % 8 == 0) ? (bx % 8) * (F.G / 8) + bx / 8 : bx; }
    unsigned char* ws = args.ws;
    F.ctl = (gu32*)(ws + WS_CTL);
    for (int u = F.tid; u < (LDS_BYTES - LDSCTL_OFF) / 4; u += NWAVES * 64) ((LAS unsigned*)(F.lds + LDSCTL_OFF))[u] = 0u;
    __syncthreads();
    XcdBarrier bar; bar.bar = (unsigned*)(F.ctl + CW_BAR); bar.x = 0; bar.st = nullptr;
    if (N_LAUNCHES == 1) bar = xcd_barrier_post((unsigned*)(F.ctl + CW_BAR), F.MISC + 8);
    const int lo = args.ph_lo, hi = args.ph_hi;
#define IN(k) (lo <= (k) && (k) < hi)
#define BOTH(k) (IN(k) && IN((k) + 1))
#define GRID_BAR() do { xcd_barrier(bar); } while (0)

    if (IN(0)) { p0_prologue(F, args); if (BOTH(0)) GRID_BAR(); }
    if (IN(1)) {
        pg8::Gemm g{(const pg8::bf16_t*)(ws + WS_XN), (const pg8::bf16_t*)(ws + WS_WIN), M, NPROJ, DM}; pg8::StaticOrder S; S.init(M, NPROJ, F.G, (int)blockIdx.x);
        pg8::EpiProj E{(pg8::bf16_t*)(ws + WS_PROJ), SEG_BYTES / 2};
        pg8::gemm_phase<pg8::EpiProj, pg8::StaticOrder, true, true>(F.lds + RING_OFF, g, S, E);
        if (BOTH(1)) GRID_BAR();
    }
    if (IN(2)) { p2_fast(F, args); if (BOTH(2)) GRID_BAR(); }
    if (IN(3)) { p3_fast(F, args); if (BOTH(3)) GRID_BAR(); }
    if (IN(4)) { p4_gate(F, args); p4_pool(F, args); if (BOTH(4)) GRID_BAR(); }
    if (IN(5)) {
        pg8::Gemm g{(const pg8::bf16_t*)(ws + WS_Y), (const pg8::bf16_t*)(ws + WS_WOUT), M, DM, DM}; pg8::StaticOrder S; S.init(M, DM, F.G, (int)blockIdx.x);
        pg8::EpiResF32 E{args.in[0], args.out, DM};
        pg8::gemm_phase<pg8::EpiResF32, pg8::StaticOrder, true, true>(F.lds + RING_OFF, g, S, E);
        if (BOTH(5)) GRID_BAR();
    }
    if (IN(6)) { p6_final_norm(F, args); }
#undef IN
#undef BOTH
}

extern "C" void kernel_launch(void* const* d_in, const int* in_sizes, int n_in, void* d_out, int out_size, void* d_ws, size_t ws_size, hipStream_t stream) {
    static int grid = 0;
    if (grid == 0) {
        if (n_in != 11 || in_sizes[0] != M * DM || out_size != M * DM || ws_size < WS_END) { fprintf(stderr, "kernel_launch: unexpected shapes: n_in %d in0 %d out %d ws %zu\n", n_in, n_in > 0 ? in_sizes[0] : -1, out_size, ws_size); grid = -1; return; }
        int dev = 0, cus = 0, per_cu = 0;
        if (hipGetDevice(&dev) != hipSuccess || hipDeviceGetAttribute(&cus, hipDeviceAttributeMultiprocessorCount, dev) != hipSuccess) { grid = -1; return; }
        if (hipFuncSetAttribute((const void*)fwd, hipFuncAttributeMaxDynamicSharedMemorySize, LDS_BYTES) != hipSuccess) { fprintf(stderr, "kernel_launch: hipFuncSetAttribute failed\n"); grid = -1; return; }
        if (hipOccupancyMaxActiveBlocksPerMultiprocessor(&per_cu, (const void*)fwd, NWAVES * 64, LDS_BYTES) != hipSuccess || per_cu < 1) fprintf(stderr, "kernel_launch: occupancy query reports %d\n", per_cu);
        (void)hipGetLastError();
        grid = 256; if (cus != 256) fprintf(stderr, "kernel_launch: expected 256 CUs, device reports %d\n", cus);
    }
    if (grid < 0) return;
    if (hipMemsetAsync((char*)d_ws + WS_CTL, 0, CTL_ZERO_BYTES, stream) != hipSuccess) return;
    Args a{};
    for (int i = 0; i < 11; ++i) a.in[i] = (const float*)d_in[i];
    a.out = (float*)d_out; a.ws = (unsigned char*)d_ws;
    for (int li = 0; li < N_LAUNCHES; ++li) {
        a.ph_lo = (N_LAUNCHES == 1) ? 0 : li; a.ph_hi = (N_LAUNCHES == 1) ? N_PHASES : li + 1;
        hipLaunchKernelGGL(fwd, dim3(grid), dim3(NWAVES * 64), LDS_BYTES, stream, a);
        if (hipPeekAtLastError() != hipSuccess) { fprintf(stderr, "kernel_launch: launch %d failed\n", li); break; }
    }
}
```
